# Optimizing an MI355X kernel written in HIP

```python
import jax, jax.numpy as jnp
from jax import lax
import numpy as np

D_MODEL = 1024
BATCH = 8
SEQ = 4096
DEPTH = 4

N_MIXERS = 2
FOURIER_GROUPS = 4
FOURIER_GROUP_DIM = D_MODEL // FOURIER_GROUPS
RET_HEADS = 4
RET_QK_DIM = D_MODEL // RET_HEADS
RET_V_DIM = 2 * RET_QK_DIM
RET_CHUNK = 128
ROPE_BASE = 10000.0
D_FF = -(-8 * D_MODEL // (3 * 256)) * 256
EPS = 1e-6

kernel_name = "hybrid_fourier_retention_adaln_encoder"


def rmsnorm(x, g):
    xf = x.astype(jnp.float32)
    y = xf * lax.rsqrt(jnp.mean(xf * xf, axis=-1, keepdims=True) + EPS)
    return (y * g.astype(jnp.float32)).astype(x.dtype)


def modulate(h, shift, scale):
    return h * (1.0 + scale[:, None, :]) + shift[:, None, :]


def fourier_mixer(h, w_o):
    B, S, D = h.shape
    hg = h.astype(jnp.float32).reshape(B, S, FOURIER_GROUPS, FOURIER_GROUP_DIM)
    f = jnp.fft.fftn(hg, axes=(1, 3), norm="ortho").real.astype(h.dtype)
    return f.reshape(B, S, D) @ w_o


def rotary(x, pos):
    half = x.shape[-1] // 2
    inv_freq = ROPE_BASE ** (-jnp.arange(half, dtype=jnp.float32) / half)
    ang = pos[:, None] * inv_freq[None, :]
    cos, sin = jnp.cos(ang), jnp.sin(ang)
    x1, x2 = x[..., :half], x[..., half:]
    return jnp.concatenate([x1 * cos - x2 * sin, x1 * sin + x2 * cos], axis=-1)


def chunk_retention(q, k, v, log_gamma, inclusive):
    B, H, S, dk = q.shape
    dv = v.shape[-1]
    C = RET_CHUNK
    N = S // C
    to_chunks = lambda a: jnp.moveaxis(a.reshape(B, H, N, C, a.shape[-1]), 2, 0)
    qc, kc, vc = to_chunks(q), to_chunks(k), to_chunks(v)

    t = jnp.arange(C)
    diff = t[:, None] - t[None, :]
    mask = (diff >= 0) if inclusive else (diff > 0)
    lg = log_gamma.astype(jnp.float32)[:, None, None]
    dmask = jnp.where(mask, jnp.exp(jnp.where(mask, diff, 0).astype(jnp.float32) * lg), 0.0)
    tf = t.astype(jnp.float32)[None, :, None]
    q_decay = jnp.exp((tf + 1.0) * lg)
    k_decay = jnp.exp((C - 1.0 - tf) * lg)
    chunk_decay = jnp.exp(C * lg)

    def step(R, xs):
        qb, kb, vb = xs
        scores = jnp.einsum('bhtd,bhsd->bhts', qb, kb) * dmask
        inner = jnp.einsum('bhts,bhsv->bhtv', scores, vb)
        cross = jnp.einsum('bhtd,bhdv->bhtv', qb, R) * q_decay
        R = R * chunk_decay + jnp.einsum('bhsd,bhsv->bhdv', kb * k_decay, vb)
        return R, inner + cross

    R0 = jnp.zeros((B, H, dk, dv), jnp.float32)
    _, out = lax.scan(step, R0, (qc, kc, vc))
    return jnp.moveaxis(out, 0, 2).reshape(B, H, S, dv)


def retention_mixer(h, w_in, w_out, log_g_fwd, log_g_bwd):
    B, S, _ = h.shape
    H, dk, dv = RET_HEADS, RET_QK_DIM, RET_V_DIM
    proj = h @ w_in
    q, k, v, g = jnp.split(proj, [H * dk, 2 * H * dk, 2 * H * dk + H * dv], axis=-1)
    heads = lambda a, d: a.astype(jnp.float32).reshape(B, S, H, d).transpose(0, 2, 1, 3)
    pos = jnp.arange(S, dtype=jnp.float32)
    q = rotary(heads(q, dk), pos)
    k = rotary(heads(k, dk), pos) * (dk ** -0.5)
    v = heads(v, dv)
    y_fwd = chunk_retention(q, k, v, log_g_fwd, True)
    flip = lambda a: jnp.flip(a, axis=2)
    y_bwd = flip(chunk_retention(flip(q), flip(k), flip(v), log_g_bwd, False))
    y = y_fwd + y_bwd
    mu = jnp.mean(y, axis=-1, keepdims=True)
    var = jnp.mean(jnp.square(y - mu), axis=-1, keepdims=True)
    y = (y - mu) * lax.rsqrt(var + EPS)
    y = y.transpose(0, 2, 1, 3).reshape(B, S, H * dv).astype(h.dtype)
    return (jax.nn.silu(g) * y) @ w_out


def swiglu(h, w_in, w_out):
    gate, up = jnp.split(h @ w_in, 2, axis=-1)
    return (jax.nn.silu(gate) * up) @ w_out


def setup_inputs(seed: int = 0) -> dict:
    key = jax.random.key(seed)
    ks = jax.random.split(key, 14)
    D, F = D_MODEL, D_FF
    n_four = len(range(0, DEPTH, N_MIXERS))
    n_ret = len(range(1, DEPTH, N_MIXERS))
    ret_in_w = 2 * RET_HEADS * RET_QK_DIM + 2 * RET_HEADS * RET_V_DIM
    ret_v_w = RET_HEADS * RET_V_DIM
    nrm = lambda k, shape, s: jax.random.normal(k, shape, jnp.float32) * s
    return {
        "x": nrm(ks[0], (BATCH, SEQ, D), 1.0),
        "c": nrm(ks[1], (BATCH, D), 1.0),
        "w_ada": nrm(ks[2], (DEPTH, D, 6 * D), 0.5 * D ** -0.5),
        "b_ada": nrm(ks[3], (DEPTH, 6 * D), 0.01),
        "norm_mix_g": 1.0 + nrm(ks[4], (DEPTH, D), 0.02),
        "norm_ffn_g": 1.0 + nrm(ks[5], (DEPTH, D), 0.02),
        "w_fourier_out": nrm(ks[6], (n_four, D, D), D ** -0.5),
        "w_ret_in": nrm(ks[7], (n_ret, D, ret_in_w), D ** -0.5),
        "w_ret_out": nrm(ks[8], (n_ret, ret_v_w, D), ret_v_w ** -0.5),
        "w_ffn_in": nrm(ks[9], (DEPTH, D, 2 * F), D ** -0.5),
        "w_ffn_out": nrm(ks[10], (DEPTH, F, D), F ** -0.5),
        "final_norm_g": 1.0 + nrm(ks[11], (D,), 0.02),
        "w_ada_final": nrm(ks[12], (D, 2 * D), 0.5 * D ** -0.5),
        "b_ada_final": nrm(ks[13], (2 * D,), 0.01),
    }


def reference(x, c, w_ada, b_ada, norm_mix_g, norm_ffn_g, w_fourier_out, w_ret_in, w_ret_out,
              w_ffn_in, w_ffn_out, final_norm_g, w_ada_final, b_ada_final):
    hidx = jnp.arange(RET_HEADS, dtype=jnp.float32)
    log_g_fwd = jnp.log1p(-jnp.exp2(-5.0 - hidx))
    log_g_bwd = jnp.flip(log_g_fwd)
    c_act = jax.nn.silu(c)
    for i in range(DEPTH):
        mod = c_act @ w_ada[i] + b_ada[i]
        sh1, sc1, g1, sh2, sc2, g2 = jnp.split(mod, 6, axis=-1)
        h = modulate(rmsnorm(x, norm_mix_g[i]), sh1, sc1)
        j = i // N_MIXERS
        if i % N_MIXERS == 0:
            m = fourier_mixer(h, w_fourier_out[j])
        else:
            m = retention_mixer(h, w_ret_in[j], w_ret_out[j], log_g_fwd, log_g_bwd)
        x = x + g1[:, None, :] * m
        h = modulate(rmsnorm(x, norm_ffn_g[i]), sh2, sc2)
        x = x + g2[:, None, :] * swiglu(h, w_ffn_in[i], w_ffn_out[i])
    shf, scf = jnp.split(c_act @ w_ada_final + b_ada_final, 2, axis=-1)
    return modulate(rmsnorm(x, final_norm_g), shf, scf)
```

```cpp
#include <hip/hip_runtime.h>
#include <hip/hip_cooperative_groups.h>
#include <cstdio>
namespace cg = cooperative_groups;

#ifndef MULTI_LAUNCH
#define MULTI_LAUNCH 0
#endif

#define LAS __attribute__((address_space(3)))
typedef unsigned short bf16_t;
typedef short bf16x8 __attribute__((ext_vector_type(8)));
typedef float f32x4 __attribute__((ext_vector_type(4)));
typedef float f32x2 __attribute__((ext_vector_type(2)));
typedef unsigned u32x4 __attribute__((ext_vector_type(4)));
typedef unsigned u32x2 __attribute__((ext_vector_type(2)));

constexpr int NTOK = 32768, SEQ = 4096, DM = 1024, DFF = 2816, HTOK = 16384;
constexpr int BM = 256, BK = 64, HALF = 128, HTB = HALF * BK * 2, STAGE_BYTES = 8 * HTB, NXCD = 8, WGM = 8;
constexpr int MODW = 26624;
constexpr int LDS_BYTES = STAGE_BYTES + 1024;
constexpr size_t MiB = 1048576;
constexpr size_t WS_MOD = 0, WS_ROPE = 1 * MiB, WS_ROPET = 5 * MiB, WS_CS = 9 * MiB, WS_STATS = 10 * MiB;
constexpr size_t WS_W = 14 * MiB;
constexpr size_t W_MIXIN = WS_W, W_MIXOUT = WS_W + 12 * MiB, W_FFNIN = WS_W + 16 * MiB, W_FFNOUT = WS_W + 27 * MiB;
constexpr size_t WS_H = 47 * MiB;
constexpr size_t WS_BIG = 111 * MiB;
constexpr size_t WS_YT = WS_BIG, WS_DFTM = WS_BIG + 128 * MiB, WS_FO = WS_BIG + 192 * MiB;
constexpr size_t WS_A2 = WS_BIG, WS_B2 = WS_BIG + 128 * MiB, WS_KTM = WS_BIG + 256 * MiB, WS_KFT = WS_BIG + 288 * MiB, WS_KBT = WS_BIG + 320 * MiB;
constexpr size_t WS_Y = WS_KTM;
constexpr size_t WS_HID = WS_BIG, WS_MODP = WS_BIG;
constexpr size_t WS_END = WS_BIG + 352 * MiB;

__device__ __forceinline__ int lds_byte(int r, int c) { const int st = (r >> 4) * 2 + (c >> 5), rr = r & 15, cc = c & 31, ob = rr * 64 + cc * 2; return st * 1024 + (ob ^ (((ob >> 9) & 1) << 5)); }
__device__ __forceinline__ void stage_rc(int b, int& R, int& C) { const int st = b / 1024, sb = b % 1024, swz = sb ^ (((sb >> 9) & 1) << 5); R = (st >> 1) * 16 + swz / 64; C = (st & 1) * 32 + (swz % 64) / 2; }
__device__ __forceinline__ int perm32(int rho) { const int n = rho >> 4, i = rho & 15; return 8 * (i >> 2) + 4 * n + (i & 3); }
__device__ __forceinline__ unsigned cvt_pk_bf16(float lo, float hi) { unsigned r; asm volatile("v_cvt_pk_bf16_f32 %0, %1, %2" : "=v"(r) : "v"(lo), "v"(hi)); return r; }
__device__ __forceinline__ u32x4 pack8(const f32x4 a, const f32x4 b) { u32x4 w; w.x = cvt_pk_bf16(a[0], a[1]); w.y = cvt_pk_bf16(a[2], a[3]); w.z = cvt_pk_bf16(b[0], b[1]); w.w = cvt_pk_bf16(b[2], b[3]); return w; }
__device__ __forceinline__ float bf_lo(unsigned w) { return __uint_as_float(w << 16); }
__device__ __forceinline__ float bf_hi(unsigned w) { return __uint_as_float(w & 0xffff0000u); }
__device__ __forceinline__ float siluf(float v) { return v / (1.0f + __expf(-v)); }
__device__ __forceinline__ float lg2gamma(int h) { return log2f(1.0f - exp2f(-5.0f - (float)h)); }

struct Unit { unsigned ao, bo; int pm, pn, z; };

struct Order {
    int nM, nN, total, G, c;
    __device__ __forceinline__ void init(int nM_, int nN_, int nz, int G_, int c_) { nM = nM_; nN = nN_; total = nM_ * nN_ * nz; G = G_; c = c_; }
    __device__ __forceinline__ bool get(int i, int& z, int& pm, int& pn) const {
        const int L = i * G + c; if (L >= total) return false;
        int wgid = L; { const int q = total / NXCD, r = total % NXCD, xcd = wgid % NXCD, off = wgid / NXCD; wgid = (xcd < r ? xcd * (q + 1) : r * (q + 1) + (xcd - r) * q) + off; }
        const int per = nM * nN; z = wgid / per; const int w = wgid % per;
        const int nig = WGM * nN, gid = w / nig, fm = gid * WGM, gsz = (nM - fm) < WGM ? (nM - fm) : WGM;
        pm = fm + ((w % nig) % gsz); pn = (w % nig) / gsz; return true;
    }
};
struct GSched {
    Order o; const char* A; const char* B; int n1, n0; unsigned a2, a1, a0, apm, b2, b1, b0, bpn;
    __device__ __forceinline__ const char* baseA() const { return A; }
    __device__ __forceinline__ const char* baseB() const { return B; }
    __device__ __forceinline__ bool next(int i, Unit& u) const {
        int z, pm, pn; if (!o.get(i, z, pm, pn)) return false;
        const int z0 = z % n0, z1 = (z / n0) % n1, z2 = z / (n0 * n1);
        u.z = z; u.pm = pm; u.pn = pn;
        u.ao = z2 * a2 + z1 * a1 + z0 * a0 + pm * apm; u.bo = z2 * b2 + z1 * b1 + z0 * b0 + pn * bpn; return true;
    }
};

template <class Epi, class Sched>
__device__ __forceinline__ void gemm_phase(const int tid, LAS unsigned char* lds, const Sched& S, const Epi& E, const int lda_, const int ldb_, const int nt_) {
    int lda = lda_, ldb = ldb_, nt = nt_; asm volatile("" : "+s"(lda), "+s"(ldb), "+s"(nt));
    const int wid = __builtin_amdgcn_readfirstlane(tid >> 6), lane = tid & 63, wr = wid >> 2, wc = wid & 3, fr = lane & 15, fq = lane >> 4;
    unsigned voffA[2], voffB[2];
#pragma unroll
    for (int i = 0; i < 2; ++i) { int R, C; stage_rc(tid * 16 + i * 8192, R, C); const int Rb = Epi::PERM ? ((R & ~31) + perm32(R & 31)) : R;
        voffA[i] = (unsigned)(R * lda + C) * 2u; voffB[i] = (unsigned)(Rb * ldb + C) * 2u; }
    const size_t kstep = (size_t)(BK * 2);
    const size_t hstepA = (size_t)HALF * lda * 2, hstepB = (size_t)HALF * ldb * 2;
    const unsigned ldsw = (unsigned)wid * 1024u;
    const int aoff = lds_byte(wr * 64 + fr, fq * 8), boff = lds_byte(wc * 32 + fr, fq * 8);
#define PG8_SA(b, h) (((b) * 2 + (h)) * HTB)
#define PG8_SB(b, h) ((4 + (b) * 2 + (h)) * HTB)
#define PG8_STAGE(bufoff, gbase, voff) do { _Pragma("unroll") for (int _i = 0; _i < 2; ++_i) \
        __builtin_amdgcn_global_load_lds((const unsigned*)((const char*)(gbase) + (voff)[_i]), (LAS unsigned*)(lds + (bufoff) + ldsw + _i * 8192), 16, 0, 0); } while (0)
#define PG8_LDA(dst, b, h) do { _Pragma("unroll") for (int m = 0; m < 4; ++m) _Pragma("unroll") for (int k = 0; k < 2; ++k) dst[m][k] = *(const LAS bf16x8*)(lds + PG8_SA(b, h) + aoff + m * 2048 + k * 1024); } while (0)
#define PG8_LDB(dst, b, h) do { _Pragma("unroll") for (int n = 0; n < 2; ++n) _Pragma("unroll") for (int k = 0; k < 2; ++k) dst[n][k] = *(const LAS bf16x8*)(lds + PG8_SB(b, h) + boff + n * 2048 + k * 1024); } while (0)
#define PG8_MMA(ai, bj, At, Bt) do { __builtin_amdgcn_s_setprio(1); _Pragma("unroll") for (int m = 0; m < 4; ++m) _Pragma("unroll") for (int n = 0; n < 2; ++n) _Pragma("unroll") for (int k = 0; k < 2; ++k) \
        acc[ai][bj][m][n] = __builtin_amdgcn_mfma_f32_16x16x32_bf16(Bt[n][k], At[m][k], acc[ai][bj][m][n], 0, 0, 0); __builtin_amdgcn_s_setprio(0); } while (0)
#define PG8_WAIT_V(n) asm volatile("s_waitcnt vmcnt(" #n ")" ::: "memory")
#define PG8_WAIT_L(n) asm volatile("s_waitcnt lgkmcnt(" #n ")" ::: "memory")
#define PG8_BAR __builtin_amdgcn_s_barrier()
#define PG8_SCHED __builtin_amdgcn_sched_barrier(0)
    LAS int* ul = (LAS int*)(lds + STAGE_BYTES);
    if (tid < 16) { Unit u; u.ao = 0; u.bo = 0; u.pm = 0; u.pn = 0; u.z = 0; const bool ok = S.next(tid, u);
        ul[tid * 8 + 0] = ok ? 1 : 0; ul[tid * 8 + 1] = (int)u.ao; ul[tid * 8 + 2] = (int)u.bo; ul[tid * 8 + 3] = u.pm; ul[tid * 8 + 4] = u.pn; ul[tid * 8 + 5] = u.z; }
    __syncthreads();
#define PG8_UNIT(i, u, ok) do { const int _i = (i); ok = _i < 16 && __builtin_amdgcn_readfirstlane(ul[(_i & 15) * 8]) != 0; \
        u.ao = (unsigned)__builtin_amdgcn_readfirstlane(ul[(_i & 15) * 8 + 1]); u.bo = (unsigned)__builtin_amdgcn_readfirstlane(ul[(_i & 15) * 8 + 2]); \
        u.pm = __builtin_amdgcn_readfirstlane(ul[(_i & 15) * 8 + 3]); u.pn = __builtin_amdgcn_readfirstlane(ul[(_i & 15) * 8 + 4]); u.z = __builtin_amdgcn_readfirstlane(ul[(_i & 15) * 8 + 5]); } while (0)
    const char* const Abase = S.baseA(); const char* const Bbase = S.baseB();
    Unit cur, nxt; int ui = 0;
    { bool ok0; PG8_UNIT(0, cur, ok0); if (!ok0) return; }
    f32x4 acc[2][2][4][2];
#pragma unroll
    for (int a = 0; a < 2; ++a)
#pragma unroll
        for (int b = 0; b < 2; ++b)
#pragma unroll
            for (int m = 0; m < 4; ++m)
#pragma unroll
                for (int n = 0; n < 2; ++n) acc[a][b][m][n] = (f32x4){0.f, 0.f, 0.f, 0.f};
    bf16x8 At[4][2], B0[2][2], B1[2][2];
    const char* cA = Abase + ((size_t)cur.ao << 8); const char* cB = Bbase + ((size_t)cur.bo << 8);
    PG8_STAGE(PG8_SB(0, 0), cB, voffB); PG8_STAGE(PG8_SA(0, 0), cA, voffA); PG8_STAGE(PG8_SB(0, 1), cB + hstepB, voffB); PG8_STAGE(PG8_SA(0, 1), cA + hstepA, voffA);
    if (wr == 1) PG8_BAR;
    PG8_WAIT_V(4); PG8_BAR;
    PG8_STAGE(PG8_SB(1, 0), cB + kstep, voffB); PG8_STAGE(PG8_SA(1, 0), cA + kstep, voffA); PG8_STAGE(PG8_SB(1, 1), cB + hstepB + kstep, voffB);
    PG8_WAIT_V(6); PG8_BAR;
    for (;;) {
        bool has_next; PG8_UNIT(ui + 1, nxt, has_next);
        const char* nA = has_next ? Abase + ((size_t)nxt.ao << 8) : cA; const char* nB = has_next ? Bbase + ((size_t)nxt.bo << 8) : cB;
        for (int t = 0; t < nt; t += 2) {
            const bool last = (t == nt - 2);
            const char* a1 = cA + (size_t)(t + 1) * kstep;
            const char* a2 = last ? nA : cA + (size_t)(t + 2) * kstep; const char* b2 = last ? nB : cB + (size_t)(t + 2) * kstep;
            const char* a3 = a2 + kstep; const char* b3 = b2 + kstep;
            PG8_LDB(B0, 0, 0); PG8_SCHED; PG8_LDA(At, 0, 0); PG8_STAGE(PG8_SA(1, 1), a1 + hstepA, voffA);
            PG8_WAIT_L(8); PG8_BAR; PG8_WAIT_L(0); PG8_MMA(0, 0, At, B0); PG8_BAR; PG8_SCHED;
            PG8_LDB(B1, 0, 1); PG8_STAGE(PG8_SB(0, 0), b2, voffB);
            PG8_BAR; PG8_WAIT_L(0); PG8_MMA(0, 1, At, B1); PG8_BAR;
            PG8_LDA(At, 0, 1); PG8_STAGE(PG8_SA(0, 0), a2, voffA);
            PG8_BAR; PG8_WAIT_L(0); PG8_MMA(1, 0, At, B0); PG8_BAR; PG8_SCHED;
            PG8_STAGE(PG8_SB(0, 1), b2 + hstepB, voffB);
            PG8_WAIT_V(6); PG8_BAR; PG8_MMA(1, 1, At, B1); PG8_BAR;
            PG8_LDB(B0, 1, 0); PG8_SCHED; PG8_LDA(At, 1, 0); PG8_STAGE(PG8_SA(0, 1), a2 + hstepA, voffA);
            PG8_WAIT_L(8); PG8_BAR; PG8_WAIT_L(0); PG8_MMA(0, 0, At, B0); PG8_BAR; PG8_SCHED;
            PG8_LDB(B1, 1, 1); PG8_STAGE(PG8_SB(1, 0), b3, voffB);
            PG8_BAR; PG8_WAIT_L(0); PG8_MMA(0, 1, At, B1); PG8_BAR;
            PG8_LDA(At, 1, 1); PG8_STAGE(PG8_SA(1, 0), a3, voffA);
            PG8_BAR; PG8_WAIT_L(0); PG8_MMA(1, 0, At, B0); PG8_BAR; PG8_SCHED;
            PG8_STAGE(PG8_SB(1, 1), b3 + hstepB, voffB);
            PG8_WAIT_V(6); PG8_BAR; PG8_MMA(1, 1, At, B1); PG8_BAR;
        }
        E(acc, cur, wr, wc, fr, fq);
        if (!has_next) break;
        if constexpr (!Epi::KEEP_ACC) {
#pragma unroll
            for (int a = 0; a < 2; ++a)
#pragma unroll
                for (int b = 0; b < 2; ++b)
#pragma unroll
                    for (int m = 0; m < 4; ++m)
#pragma unroll
                        for (int n = 0; n < 2; ++n) acc[a][b][m][n] = (f32x4){0.f, 0.f, 0.f, 0.f};
        }
        cur = nxt; cA = nA; cB = nB; ++ui;
    }
    PG8_WAIT_V(0);
    if (wr == 0) PG8_BAR;
    PG8_BAR;
#undef PG8_UNIT
#undef PG8_SA
#undef PG8_SB
#undef PG8_STAGE
#undef PG8_LDA
#undef PG8_LDB
#undef PG8_MMA
#undef PG8_WAIT_V
#undef PG8_WAIT_L
#undef PG8_BAR
#undef PG8_SCHED
}

typedef f32x4 Acc[2][2][4][2];

struct EpiResid {
    static constexpr bool PERM = false, KEEP_ACC = false;
    const float* base; float* out; const float* gate  ; int row0;
    __device__ __forceinline__ void operator()(Acc& acc, const Unit& u, int wr, int wc, int fr, int fq) const {
        const int rowt = row0 + u.pm * BM, b = rowt / SEQ; const int col0 = u.pn * BM + wc * 32 + 4 * fq;
        f32x4 gv[2][2];
#pragma unroll
        for (int bj = 0; bj < 2; ++bj)
#pragma unroll
            for (int n = 0; n < 2; ++n) gv[bj][n] = *(const f32x4*)(gate + (size_t)b * MODW + col0 + bj * HALF + n * 16);
#pragma unroll
        for (int ai = 0; ai < 2; ++ai)
#pragma unroll
            for (int m = 0; m < 4; ++m) { const size_t off = (size_t)(rowt + ai * HALF + wr * 64 + m * 16 + fr) * DM + col0;
#pragma unroll
                for (int bj = 0; bj < 2; ++bj)
#pragma unroll
                    for (int n = 0; n < 2; ++n) { const f32x4 bs = *(const f32x4*)(base + off + bj * HALF + n * 16);
                        *(f32x4*)(out + off + bj * HALF + n * 16) = bs + gv[bj][n] * acc[ai][bj][m][n]; }
                asm volatile("" ::: "memory"); }
    }
};
struct EpiBf16 {
    static constexpr bool PERM = true, KEEP_ACC = false;
    bf16_t* O; int ldo; int zrows;
    __device__ __forceinline__ void operator()(Acc& acc, const Unit& u, int wr, int wc, int fr, int fq) const {
        const int row0 = u.z * zrows + u.pm * BM + wr * 64 + fr, col0 = u.pn * BM + wc * 32 + 8 * fq;
#pragma unroll
        for (int ai = 0; ai < 2; ++ai)
#pragma unroll
            for (int m = 0; m < 4; ++m) { bf16_t* rowp = O + (size_t)(row0 + ai * HALF + m * 16) * ldo + col0;
#pragma unroll
                for (int bj = 0; bj < 2; ++bj) *(u32x4*)(rowp + bj * HALF) = pack8(acc[ai][bj][m][0], acc[ai][bj][m][1]); }
    }
};
struct EpiChanDft {
    static constexpr bool PERM = true, KEEP_ACC = false;
    bf16_t* YT;
    __device__ __forceinline__ void operator()(Acc& acc, const Unit& u, int wr, int wc, int fr, int fq) const {
        const int tok0 = u.pn * BM + wc * 32 + 8 * fq, b = tok0 / SEQ, s0 = tok0 % SEQ;
#pragma unroll
        for (int ai = 0; ai < 2; ++ai)
#pragma unroll
            for (int m = 0; m < 4; ++m) { const int j = ai * HALF + wr * 64 + m * 16 + fr;
                bf16_t* rowp = YT + ((size_t)(b * DM + u.z * 256 + j) * 8192 + u.pm * SEQ + s0);
#pragma unroll
                for (int bj = 0; bj < 2; ++bj) *(u32x4*)(rowp + bj * HALF) = pack8(acc[ai][bj][m][0], acc[ai][bj][m][1]); }
    }
};
struct EpiSwiglu {
    static constexpr bool PERM = true, KEEP_ACC = false;
    bf16_t* O;
    __device__ __forceinline__ void operator()(Acc& acc, const Unit& u, int wr, int wc, int fr, int fq) const {
        const int row0 = u.pm * BM + wr * 64 + fr, col0 = u.pn * HALF + wc * 32 + 8 * fq;
#pragma unroll
        for (int ai = 0; ai < 2; ++ai)
#pragma unroll
            for (int m = 0; m < 4; ++m) { f32x4 v0, v1;
#pragma unroll
                for (int e = 0; e < 4; ++e) { v0[e] = siluf(acc[ai][0][m][0][e]) * acc[ai][1][m][0][e]; v1[e] = siluf(acc[ai][0][m][1][e]) * acc[ai][1][m][1][e]; }
                *(u32x4*)(O + (size_t)(row0 + ai * HALF + m * 16) * DFF + col0) = pack8(v0, v1); }
    }
};
struct EpiQK {
    static constexpr bool PERM = true, KEEP_ACC = false;
    bf16_t* A2; bf16_t* KTM; const float* rope  ;
    __device__ __forceinline__ void operator()(Acc& acc, const Unit& u, int wr, int wc, int fr, int fq) const {
        const bool isq = u.pn < 4; const int h = isq ? u.pn : u.pn - 4; const int i0 = wc * 32 + 8 * fq;
        const float lgf = lg2gamma(h), lgb = lg2gamma(3 - h);
#pragma unroll
        for (int ai = 0; ai < 2; ++ai)
#pragma unroll
            for (int m = 0; m < 4; ++m) {
                const int tl = u.pm * BM + ai * HALF + wr * 64 + m * 16 + fr, s = tl % SEQ, sl = s % 512;
                const f32x4* rp = (const f32x4*)(rope + ((size_t)s * 128 + i0) * 2);
                f32x4 o1[2], o2[2];
#pragma unroll
                for (int n = 0; n < 2; ++n) { const f32x4 r0 = rp[2 * n], r1 = rp[2 * n + 1]; const f32x4 x1 = acc[ai][0][m][n], x2 = acc[ai][1][m][n];
                    const float cs[4] = {r0[0], r0[2], r1[0], r1[2]}, sn[4] = {r0[1], r0[3], r1[1], r1[3]};
#pragma unroll
                    for (int e = 0; e < 4; ++e) { o1[n][e] = x1[e] * cs[e] - x2[e] * sn[e]; o2[n][e] = x1[e] * sn[e] + x2[e] * cs[e]; } }
                if (isq) {
                    const float df = exp2f((float)(sl + 1) * lgf), db = exp2f((float)(512 - sl) * lgb);
                    bf16_t* rowp = A2 + ((size_t)tl * 4 + h) * 1024 + 512 + i0;
                    *(u32x4*)(rowp) = pack8(o1[0] * df, o1[1] * df); *(u32x4*)(rowp + 128) = pack8(o2[0] * df, o2[1] * df);
                    *(u32x4*)(rowp + 256) = pack8(o1[0] * db, o1[1] * db); *(u32x4*)(rowp + 384) = pack8(o2[0] * db, o2[1] * db);
                } else {
                    bf16_t* rowp = KTM + (size_t)tl * 1024 + h * 256 + i0;
                    *(u32x4*)(rowp) = pack8(o1[0] * 0.0625f, o1[1] * 0.0625f); *(u32x4*)(rowp + 128) = pack8(o2[0] * 0.0625f, o2[1] * 0.0625f);
                }
            }
    }
};
struct EpiKVT {
    static constexpr bool PERM = true, KEEP_ACC = false;
    bf16_t* KFT; bf16_t* KBT; bf16_t* B2; const float* ropet  ;
    __device__ __forceinline__ void operator()(Acc& acc, const Unit& u, int wr, int wc, int fr, int fq) const {
        if (u.pm < 4) {
            const int h = u.pm; const float lgf = lg2gamma(h), lgb = lg2gamma(3 - h);
#pragma unroll
            for (int bj = 0; bj < 2; ++bj) {
                const int tl0 = u.pn * BM + bj * HALF + wc * 32 + 8 * fq, b = tl0 / SEQ, s0 = tl0 % SEQ, sl0 = s0 % 512;
                f32x4 kfd[2], kbd[2];
#pragma unroll
                for (int n = 0; n < 2; ++n)
#pragma unroll
                    for (int e = 0; e < 4; ++e) { const int sl = sl0 + 4 * n + e; kfd[n][e] = 0.0625f * exp2f((float)(511 - sl) * lgf); kbd[n][e] = 0.0625f * exp2f((float)sl * lgb); }
#pragma unroll
                for (int m = 0; m < 4; ++m) {
                    const int i = wr * 64 + m * 16 + fr;
                    const f32x4* rp = (const f32x4*)(ropet + ((size_t)i * SEQ + s0) * 2);
                    f32x4 o1[2], o2[2];
#pragma unroll
                    for (int n = 0; n < 2; ++n) { const f32x4 r0 = rp[2 * n], r1 = rp[2 * n + 1]; const f32x4 x1 = acc[0][bj][m][n], x2 = acc[1][bj][m][n];
                        const float cs[4] = {r0[0], r0[2], r1[0], r1[2]}, sn[4] = {r0[1], r0[3], r1[1], r1[3]};
#pragma unroll
                        for (int e = 0; e < 4; ++e) { o1[n][e] = x1[e] * cs[e] - x2[e] * sn[e]; o2[n][e] = x1[e] * sn[e] + x2[e] * cs[e]; } }
                    const size_t r1off = ((size_t)(b * 4 + h) * 256 + i) * SEQ + s0, r2off = r1off + (size_t)128 * SEQ;
                    *(u32x4*)(KFT + r1off) = pack8(o1[0] * kfd[0], o1[1] * kfd[1]); *(u32x4*)(KFT + r2off) = pack8(o2[0] * kfd[0], o2[1] * kfd[1]);
                    *(u32x4*)(KBT + r1off) = pack8(o1[0] * kbd[0], o1[1] * kbd[1]); *(u32x4*)(KBT + r2off) = pack8(o2[0] * kbd[0], o2[1] * kbd[1]);
                }
            }
        } else {
            const int h = (u.pm - 4) >> 1, dv0 = ((u.pm - 4) & 1) * 256;
#pragma unroll
            for (int bj = 0; bj < 2; ++bj) {
                const int tl0 = u.pn * BM + bj * HALF + wc * 32 + 8 * fq, b = tl0 / SEQ, s0 = tl0 % SEQ, np = s0 / 512, sl0 = s0 % 512;
#pragma unroll
                for (int ai = 0; ai < 2; ++ai)
#pragma unroll
                    for (int m = 0; m < 4; ++m) { const int dv = dv0 + ai * HALF + wr * 64 + m * 16 + fr;
                        *(u32x4*)(B2 + (((size_t)((b * 4 + h) * 8 + np) * 512 + dv) * 1024 + sl0)) = pack8(acc[ai][bj][m][0], acc[ai][bj][m][1]); }
            }
        }
    }
};
struct EpiScores {
    static constexpr bool PERM = true, KEEP_ACC = false;
    bf16_t* A2;
    __device__ __forceinline__ void operator()(Acc& acc, const Unit& u, int wr, int wc, int fr, int fq) const {
        const int np = u.z % 8, h = (u.z / 8) % 4, b = u.z / 32; const float lgf = lg2gamma(h), lgb = lg2gamma(3 - h);
#pragma unroll
        for (int ai = 0; ai < 2; ++ai)
#pragma unroll
            for (int m = 0; m < 4; ++m) { const int t = u.pm * BM + ai * HALF + wr * 64 + m * 16 + fr; const float tf = -(float)(t + 1) * lgf;
                bf16_t* rowp = A2 + ((size_t)(b * SEQ + np * 512 + t) * 4 + h) * 1024;
#pragma unroll
                for (int bj = 0; bj < 2; ++bj) { const int s0 = u.pn * BM + bj * HALF + wc * 32 + 8 * fq; f32x4 v[2];
#pragma unroll
                    for (int n = 0; n < 2; ++n)
#pragma unroll
                        for (int e = 0; e < 4; ++e) { const int s = s0 + 4 * n + e; const float ex = (s <= t) ? -(float)(s + 1) * lgf : (float)(s - t) * lgb + tf; v[n][e] = acc[ai][bj][m][n][e] * exp2f(ex); }
                    *(u32x4*)(rowp + s0) = pack8(v[0], v[1]); } }
    }
};
struct EpiScan {
    static constexpr bool PERM = true, KEEP_ACC = true;
    bf16_t* B2; int bh, dir, dvh; float dec;
    __device__ __forceinline__ void operator()(Acc& acc, const Unit& u, int wr, int wc, int fr, int fq) const {
        const int slot = u.z;
        const int col0 = 512 + dir * 256 + wc * 32 + 8 * fq;
#pragma unroll
        for (int ai = 0; ai < 2; ++ai)
#pragma unroll
            for (int m = 0; m < 4; ++m) { const int dv = dvh * 256 + ai * HALF + wr * 64 + m * 16 + fr;
                bf16_t* rowp = B2 + ((size_t)(bh * 8 + slot) * 512 + dv) * 1024 + col0;
#pragma unroll
                for (int bj = 0; bj < 2; ++bj) { *(u32x4*)(rowp + bj * HALF) = pack8(acc[ai][bj][m][0], acc[ai][bj][m][1]);
                    acc[ai][bj][m][0] *= dec; acc[ai][bj][m][1] *= dec; } }
    }
};
struct ScanSched {
    const char* B2; const char* KT; int bh, dir, dvh;
    __device__ __forceinline__ const char* baseA() const { return B2; }
    __device__ __forceinline__ const char* baseB() const { return KT; }
    __device__ __forceinline__ bool next(int i, Unit& u) const {
        if (i >= 7) return false;
        const int ci = dir ? 7 - i : i; u.pm = 0; u.pn = 0; u.z = dir ? ci - 1 : ci + 1;
        u.ao = (unsigned)(((bh * 8 + ci) * 512 + dvh * 256) * 8);
        u.bo = (unsigned)(bh * 256 * 32 + ci * 4);
        return true;
    }
};
struct EpiRetOut {
    static constexpr bool PERM = true, KEEP_ACC = false;
    bf16_t* Y; float* stats;
    __device__ __forceinline__ void operator()(Acc& acc, const Unit& u, int wr, int wc, int fr, int fq) const {
        const int np = u.z % 8, h = (u.z / 8) % 4, b = u.z / 32;
#pragma unroll
        for (int ai = 0; ai < 2; ++ai)
#pragma unroll
            for (int m = 0; m < 4; ++m) { const int tl = b * SEQ + np * 512 + u.pm * BM + ai * HALF + wr * 64 + m * 16 + fr;
                float s = 0.f, q = 0.f;
#pragma unroll
                for (int bj = 0; bj < 2; ++bj)
#pragma unroll
                    for (int n = 0; n < 2; ++n) { const f32x4 x = acc[ai][bj][m][n]; s += (x[0] + x[1]) + (x[2] + x[3]); q += (x[0] * x[0] + x[1] * x[1]) + (x[2] * x[2] + x[3] * x[3]); }
                s += __shfl_xor(s, 16); s += __shfl_xor(s, 32); q += __shfl_xor(q, 16); q += __shfl_xor(q, 32);
                if (fq == 0) *(f32x2*)(stats + (((size_t)tl * 4 + h) * 8 + u.pn * 4 + wc) * 2) = (f32x2){s, q};
                bf16_t* rowp = Y + (size_t)tl * 2048 + h * 512 + u.pn * BM + wc * 32 + 8 * fq;
#pragma unroll
                for (int bj = 0; bj < 2; ++bj) *(u32x4*)(rowp + bj * HALF) = pack8(acc[ai][bj][m][0], acc[ai][bj][m][1]); }
    }
};
struct EpiGate {
    static constexpr bool PERM = true, KEEP_ACC = false;
    bf16_t* Y; const float* stats;
    __device__ __forceinline__ void operator()(Acc& acc, const Unit& u, int wr, int wc, int fr, int fq) const {
        const int h = u.pn >> 1;
#pragma unroll
        for (int ai = 0; ai < 2; ++ai)
#pragma unroll
            for (int m = 0; m < 4; ++m) { const int tl = u.pm * BM + ai * HALF + wr * 64 + m * 16 + fr;
                const f32x4* sp = (const f32x4*)(stats + ((size_t)tl * 4 + h) * 16); float s = 0.f, q = 0.f;
#pragma unroll
                for (int k = 0; k < 4; ++k) { const f32x4 v = sp[k]; s += v[0] + v[2]; q += v[1] + v[3]; }
                const float mu = s * (1.0f / 512.0f), var = fmaxf(q * (1.0f / 512.0f) - mu * mu, 0.f), rstd = rsqrtf(var + 1e-6f);
                bf16_t* rowp = Y + (size_t)tl * 2048 + u.pn * BM + wc * 32 + 8 * fq;
#pragma unroll
                for (int bj = 0; bj < 2; ++bj) { const u32x4 yw = *(const u32x4*)(rowp + bj * HALF);
                    const float yv[8] = {bf_lo(yw.x), bf_hi(yw.x), bf_lo(yw.y), bf_hi(yw.y), bf_lo(yw.z), bf_hi(yw.z), bf_lo(yw.w), bf_hi(yw.w)};
                    f32x4 v0, v1;
#pragma unroll
                    for (int e = 0; e < 4; ++e) { v0[e] = siluf(acc[ai][bj][m][0][e]) * (yv[e] - mu) * rstd; v1[e] = siluf(acc[ai][bj][m][1][e]) * (yv[4 + e] - mu) * rstd; }
                    *(u32x4*)(rowp + bj * HALF) = pack8(v0, v1); }
                asm volatile("" ::: "memory"); }
    }
};

template <int MODE>
__device__ __forceinline__ void conv_weight(const int tid, LAS float* tile, const float* W, int K, int N, bf16_t* WT, int tile0, int tstride) {
    const int ntn = N / 64, ntiles = (K / 64) * ntn;
#pragma unroll 1
    for (int t = tile0; t < ntiles; t += tstride) {
        const int k0 = (t / ntn) * 64, n0 = (t % ntn) * 64;
        __syncthreads();
#pragma unroll
        for (int p = 0; p < 2; ++p) { const int kk = p * 32 + (tid >> 4), c4 = (tid & 15) * 4; const f32x4 v = *(const f32x4*)(W + (size_t)(k0 + kk) * N + n0 + c4);
            tile[kk * 65 + c4] = v[0]; tile[kk * 65 + c4 + 1] = v[1]; tile[kk * 65 + c4 + 2] = v[2]; tile[kk * 65 + c4 + 3] = v[3]; }
        __syncthreads();
        const int n = tid >> 3, ks = (tid & 7) * 8; float v[8];
#pragma unroll
        for (int e = 0; e < 8; ++e) v[e] = tile[(ks + e) * 65 + n];
        int nn = n0 + n;
        if (MODE == 1) { const int j = nn < DFF ? nn : nn - DFF; nn = 256 * (j >> 7) + (nn < DFF ? 0 : 128) + (j & 127); }
        u32x4 w; w.x = cvt_pk_bf16(v[0], v[1]); w.y = cvt_pk_bf16(v[2], v[3]); w.z = cvt_pk_bf16(v[4], v[5]); w.w = cvt_pk_bf16(v[6], v[7]);
        *(u32x4*)(WT + (size_t)nn * K + k0 + ks) = w;
    }
}
template <bool FINAL>
__device__ __forceinline__ void norm_rows(const int tid, const int bx, const int G, const float* x, const float* g, const float* mod, int shoff, int scoff, bf16_t* h, float* outf) {
    const int lane = tid & 63, gw = bx * 8 + (tid >> 6), nw = G * 8;
#pragma unroll 2
    for (int r = gw; r < NTOK; r += nw) {
        const int b = r / SEQ; f32x4 v[4]; float ss = 0.f;
#pragma unroll
        for (int j = 0; j < 4; ++j) { v[j] = *(const f32x4*)(x + (size_t)r * DM + j * 256 + lane * 4); ss += (v[j][0] * v[j][0] + v[j][1] * v[j][1]) + (v[j][2] * v[j][2] + v[j][3] * v[j][3]); }
#pragma unroll
        for (int o = 32; o >= 1; o >>= 1) ss += __shfl_xor(ss, o);
        const float rs = rsqrtf(ss * (1.0f / 1024.0f) + 1e-6f);
#pragma unroll
        for (int j = 0; j < 4; ++j) { const int col = j * 256 + lane * 4;
            const f32x4 gg = *(const f32x4*)(g + col), sc = *(const f32x4*)(mod + (size_t)b * MODW + scoff + col), sh = *(const f32x4*)(mod + (size_t)b * MODW + shoff + col);
            const f32x4 y = (v[j] * rs) * gg * (sc + 1.0f) + sh;
            if (FINAL) *(f32x4*)(outf + (size_t)r * DM + col) = y;
            else { u32x2 w; w.x = cvt_pk_bf16(y[0], y[1]); w.y = cvt_pk_bf16(y[2], y[3]); *(u32x2*)(h + (size_t)r * DM + col) = w; } }
    }
}

struct Params { const float* in[14]; float* out; unsigned char* ws; int ph_lo, ph_hi; };

enum { K_GEMV = 0, K_MODFIN, K_PREP, K_F1, K_F2, K_N2, K_FF1, K_RESID, K_P1, K_P2S, K_P5, K_GATE, K_FINAL };
enum { R_F3 = 0, R_WOUT, R_FF2 };

__device__ __forceinline__ void plain_sched(GSched& S, int nM, int nN, int G, int c, const void* A, const void* B, int lda, int ldb) {
    S.o.init(nM, nN, 1, G, c); S.A = (const char*)A; S.B = (const char*)B; S.n1 = 1; S.n0 = 1;
    S.a2 = 0; S.a1 = 0; S.a0 = 0; S.apm = (unsigned)(2 * lda); S.b2 = 0; S.b1 = 0; S.b0 = 0; S.bpn = (unsigned)(2 * ldb);
}

__global__ void __launch_bounds__(512, 2) mega(Params p) {
    extern __shared__ __attribute__((aligned(16))) unsigned char shm[];
    for (int ph = p.ph_lo; ph < p.ph_hi; ++ph) {
        int tid_ = threadIdx.x, G_ = gridDim.x, bx_ = blockIdx.x; unsigned char* ws_ = p.ws; float* xres_ = p.out; unsigned ldsa = 0;
        asm volatile("" : "+v"(tid_), "+s"(G_), "+s"(bx_), "+s"(ldsa));
        const int tid = tid_, lane = tid & 63, wid = tid >> 6, G = G_, bx = bx_; unsigned char* const ws = ws_; float* const xres = xres_;
        LAS unsigned char* const lds = (LAS unsigned char*)shm + ldsa;
        int kind, l = 0, half = 0, rk = 0;
        if (ph < 2) kind = ph;
        else if (ph == 44) kind = K_FINAL;
        else {
            const int q = ph - 2, pair = q / 21, r = q % 21;
            if (r < 7) { l = 2 * pair; kind = r == 0 ? K_PREP : r == 1 ? K_F1 : r == 2 ? K_F2 : r == 3 ? K_RESID : r == 4 ? K_N2 : r == 5 ? K_FF1 : K_RESID; rk = r == 3 ? R_F3 : R_FF2; }
            else { l = 2 * pair + 1; const int r2 = r - 7;
                if (r2 == 0) kind = K_PREP;
                else if (r2 <= 10) { half = (r2 - 1) / 5; const int sub = (r2 - 1) % 5; kind = sub == 0 ? K_P1 : sub == 1 ? K_P2S : sub == 2 ? K_P5 : sub == 3 ? K_GATE : K_RESID; rk = R_WOUT; }
                else { kind = r2 == 11 ? K_N2 : r2 == 12 ? K_FF1 : K_RESID; rk = R_FF2; } }
        }
        float* MOD = (float*)(ws + WS_MOD);
        const float* modl = MOD + l * 6144;
        bf16_t* H = (bf16_t*)(ws + WS_H);
        const float* xcur = l == 0 ? p.in[0] : xres;
        switch (kind) {
        case K_GEMV: {
            const float* c_in = p.in[1]; const float* w_ada = p.in[2]; const float* w_ada_f = p.in[12];
            float* MODP = (float*)(ws + WS_MODP); float* ROPE = (float*)(ws + WS_ROPE); float* ROPET = (float*)(ws + WS_ROPET); bf16_t* CS = (bf16_t*)(ws + WS_CS);
            LAS float* cact = (LAS float*)lds;
            for (int i = tid; i < 8 * DM; i += 512) { const float v = c_in[i]; cact[i] = v / (1.0f + __expf(-v)); }
            __syncthreads();
            int vz = 0; asm volatile("" : "+v"(vz));
#pragma unroll 1
            for (int w = bx * 8 + wid; w < 104 * 16; w += G * 8) {
                const int cgp = w % 104, ks = w / 104, gc = cgp * 256 + lane * 4;
                const float* Wp; int ldw;
                if (gc < 24576) { const int ll = gc / 6144; Wp = w_ada + (size_t)ll * DM * 6144 + (gc - ll * 6144); ldw = 6144; } else { Wp = w_ada_f + (gc - 24576); ldw = 2048; }
                f32x4 a[8];
#pragma unroll
                for (int b = 0; b < 8; ++b) a[b] = (f32x4){0.f, 0.f, 0.f, 0.f};
#pragma unroll 4
                for (int k = ks * 64; k < ks * 64 + 64; ++k) { const f32x4 wv = *(const f32x4*)(Wp + (size_t)k * ldw);
#pragma unroll
                    for (int b = 0; b < 8; ++b) a[b] += wv * cact[b * DM + k + vz]; }
#pragma unroll
                for (int b = 0; b < 8; ++b) *(f32x4*)(MODP + ((size_t)(ks * 8 + b)) * MODW + gc) = a[b];
            }
#pragma unroll 1
            for (int idx = bx * 512 + tid; idx < SEQ * 128; idx += G * 512) {
                const int s = idx >> 7, i = idx & 127;
                const float invf = exp2f(-(float)i * (13.287712379549449f / 128.0f));
                const float ang = (float)s * invf;
                const double rev = (double)ang * 0.15915494309189535; const float fr_ = (float)(rev - floor(rev));
                const float sn = __builtin_amdgcn_sinf(fr_), cs = __builtin_amdgcn_cosf(fr_);
                *(f32x2*)(ROPE + (size_t)idx * 2) = (f32x2){cs, sn};
                *(f32x2*)(ROPET + ((size_t)i * SEQ + s) * 2) = (f32x2){cs, sn};
            }
#pragma unroll 1
            for (int idx = bx * 512 + tid; idx < 512 * 256; idx += G * 512) {
                const int row = idx >> 8, d = idx & 255, j = row & 255, part = row >> 8; const float fr_ = (float)((j * d) & 255) * (1.0f / 256.0f);
                const float v = (part ? __builtin_amdgcn_sinf(fr_) : __builtin_amdgcn_cosf(fr_)) * 0.0625f;
                CS[idx] = (bf16_t)(cvt_pk_bf16(v, 0.f) & 0xffffu);
            }
        } break;
        case K_MODFIN: {
            const float* b_ada = p.in[3]; const float* b_ada_f = p.in[13]; const float* MODP = (const float*)(ws + WS_MODP);
#pragma unroll 1
            for (int idx = bx * 512 + tid; idx < 8 * MODW; idx += G * 512) {
                const int b = idx / MODW, gc = idx % MODW; float s = gc < 24576 ? b_ada[gc] : b_ada_f[gc - 24576];
#pragma unroll
                for (int ks = 0; ks < 16; ++ks) s += MODP[((size_t)(ks * 8 + b)) * MODW + gc];
                MOD[idx] = s;
            }
        } break;
        case K_PREP: {
            const bool fourier = (l & 1) == 0; const int j = l >> 1;
            LAS float* tile = (LAS float*)lds;
            if (fourier) {
                conv_weight<0>(tid, tile, p.in[6] + (size_t)j * DM * DM, DM, DM, (bf16_t*)(ws + W_MIXIN), bx, G);
            } else {
                conv_weight<0>(tid, tile, p.in[7] + (size_t)j * DM * 6144, DM, 6144, (bf16_t*)(ws + W_MIXIN), bx, G);
                conv_weight<0>(tid, tile, p.in[8] + (size_t)j * 2048 * DM, 2048, DM, (bf16_t*)(ws + W_MIXOUT), bx, G);
            }
            conv_weight<1>(tid, tile, p.in[9] + (size_t)l * DM * 2 * DFF, DM, 2 * DFF, (bf16_t*)(ws + W_FFNIN), bx, G);
            conv_weight<0>(tid, tile, p.in[10] + (size_t)l * DFF * DM, DFF, DM, (bf16_t*)(ws + W_FFNOUT), bx, G);
            __syncthreads();
            if (fourier) {
                LAS float* tc = (LAS float*)lds; LAS float* tsn = tc + SEQ;
                for (int i = tid; i < SEQ; i += 512) { const float fr_ = (float)i * (1.0f / 4096.0f); tc[i] = __builtin_amdgcn_cosf(fr_) * (1.0f / 64.0f); tsn[i] = -__builtin_amdgcn_sinf(fr_) * (1.0f / 64.0f); }
                __syncthreads();
                bf16_t* DFTM = (bf16_t*)(ws + WS_DFTM);
#pragma unroll 1
                for (int k = bx; k < SEQ; k += G) {
#pragma unroll
                    for (int q = 0; q < 2; ++q) { const int c0 = (q * 512 + tid) * 8, part = c0 >> 12, s0 = c0 & 4095; LAS float* tb = part ? tsn : tc; float v[8];
#pragma unroll
                        for (int e = 0; e < 8; ++e) v[e] = tb[(k * (s0 + e)) & 4095];
                        u32x4 w; w.x = cvt_pk_bf16(v[0], v[1]); w.y = cvt_pk_bf16(v[2], v[3]); w.z = cvt_pk_bf16(v[4], v[5]); w.w = cvt_pk_bf16(v[6], v[7]);
                        *(u32x4*)(DFTM + (size_t)k * 8192 + c0) = w; }
                }
                __syncthreads();
            }
            norm_rows<false>(tid, bx, G, xcur, p.in[4] + l * DM, modl, 0, 1024, H, nullptr);
        } break;
        case K_F1: {
            GSched S; S.o.init(2, 128, 4, G, bx); S.A = (const char*)(ws + WS_CS); S.B = (const char*)H; S.n1 = 1; S.n0 = 4;
            S.a2 = 0; S.a1 = 0; S.a0 = 0; S.apm = 2 * 256; S.b2 = 0; S.b1 = 0; S.b0 = 2; S.bpn = 2 * DM;
            EpiChanDft E{(bf16_t*)(ws + WS_YT)};
            gemm_phase(tid, lds, S, E, 256, DM, 4);
        } break;
        case K_F2: {
            GSched S; S.o.init(16, 4, 8, G, bx); S.A = (const char*)(ws + WS_DFTM); S.B = (const char*)(ws + WS_YT); S.n1 = 1; S.n0 = 8;
            S.a2 = 0; S.a1 = 0; S.a0 = 0; S.apm = 2 * 8192; S.b2 = 0; S.b1 = 0; S.b0 = DM * 64; S.bpn = 2 * 8192;
            EpiBf16 E{(bf16_t*)(ws + WS_FO), DM, SEQ};
            gemm_phase(tid, lds, S, E, 8192, 8192, 128);
        } break;
        case K_N2: {
            norm_rows<false>(tid, bx, G, xres, p.in[5] + l * DM, modl, 3072, 4096, H, nullptr);
        } break;
        case K_FF1: {
            GSched S; plain_sched(S, 128, 22, G, bx, H, ws + W_FFNIN, DM, DM);
            EpiSwiglu E{(bf16_t*)(ws + WS_HID)};
            gemm_phase(tid, lds, S, E, DM, DM, 16);
        } break;
        case K_RESID: {
            GSched S; EpiResid E; int ld, nt;
            if (rk == R_F3) { ld = DM; nt = 16; plain_sched(S, 128, 4, G, bx, ws + WS_FO, ws + W_MIXIN, ld, ld); E = EpiResid{xcur, xres, modl + 2048, 0}; }
            else if (rk == R_WOUT) { ld = 2048; nt = 32; plain_sched(S, 64, 4, G, bx, ws + WS_Y, ws + W_MIXOUT, ld, ld); E = EpiResid{xres, xres, modl + 2048, half * HTOK}; }
            else { ld = DFF; nt = 44; plain_sched(S, 128, 4, G, bx, ws + WS_HID, ws + W_FFNOUT, ld, ld); E = EpiResid{xres, xres, modl + 5120, 0}; }
            gemm_phase(tid, lds, S, E, ld, ld, nt);
        } break;
        case K_P1: {
            const bf16_t* Hh = H + (size_t)half * HTOK * DM; const bf16_t* WTin = (const bf16_t*)(ws + W_MIXIN);
            { GSched S; plain_sched(S, 64, 8, G, bx, Hh, WTin, DM, DM);
              EpiQK E{(bf16_t*)(ws + WS_A2), (bf16_t*)(ws + WS_KTM), (const float*)(ws + WS_ROPE)};
              gemm_phase(tid, lds, S, E, DM, DM, 16); }
            { GSched S; plain_sched(S, 12, 64, G, bx, WTin + (size_t)1024 * DM, Hh, DM, DM);
              EpiKVT E{(bf16_t*)(ws + WS_KFT), (bf16_t*)(ws + WS_KBT), (bf16_t*)(ws + WS_B2), (const float*)(ws + WS_ROPET)};
              gemm_phase(tid, lds, S, E, DM, DM, 16); }
        } break;
        case K_P2S: {
            bf16_t* A2 = (bf16_t*)(ws + WS_A2); bf16_t* B2 = (bf16_t*)(ws + WS_B2);
            if (bx < 64) {
                const int bh = bx >> 2, dir = (bx >> 1) & 1, dvh = bx & 1, h = bh & 3;
                { unsigned zz = 0; asm volatile("" : "+v"(zz)); const int slot = dir ? 7 : 0;
                  for (int i = tid; i < 256 * 32; i += 512) { const int r = i >> 5, c8 = (i & 31) * 8;
                      *(u32x4*)(B2 + ((size_t)(bh * 8 + slot) * 512 + dvh * 256 + r) * 1024 + 512 + dir * 256 + c8) = (u32x4){zz, zz, zz, zz}; } }
                ScanSched S{(const char*)B2, (const char*)(ws + (dir ? WS_KBT : WS_KFT)), bh, dir, dvh};
                EpiScan E{B2, bh, dir, dvh, exp2f(512.0f * lg2gamma(dir ? 3 - h : h))};
                gemm_phase(tid, lds, S, E, 1024, SEQ, 8);
            } else {
                GSched S; S.o.init(2, 2, 128, G - 64, bx - 64); S.A = (const char*)(A2 + 512); S.B = (const char*)(ws + WS_KTM); S.n1 = 4; S.n0 = 8;
                S.a2 = SEQ * 32; S.a1 = 8; S.a0 = 512 * 32; S.apm = 256 * 32;
                S.b2 = SEQ * 8; S.b1 = 2; S.b0 = 512 * 8; S.bpn = 256 * 8;
                EpiScores E{A2};
                gemm_phase(tid, lds, S, E, 4096, DM, 4);
            }
        } break;
        case K_P5: {
            GSched S; S.o.init(2, 2, 128, G, bx); S.A = (const char*)(ws + WS_A2); S.B = (const char*)(ws + WS_B2); S.n1 = 4; S.n0 = 8;
            S.a2 = SEQ * 32; S.a1 = 8; S.a0 = 512 * 32; S.apm = 256 * 32;
            S.b2 = 32 * 512 * 8; S.b1 = 8 * 512 * 8; S.b0 = 512 * 8; S.bpn = 256 * 8;
            EpiRetOut E{(bf16_t*)(ws + WS_Y), (float*)(ws + WS_STATS)};
            gemm_phase(tid, lds, S, E, 4096, 1024, 16);
        } break;
        case K_GATE: {
            GSched S; plain_sched(S, 64, 8, G, bx, H + (size_t)half * HTOK * DM, (const bf16_t*)(ws + W_MIXIN) + (size_t)4096 * DM, DM, DM);
            EpiGate E{(bf16_t*)(ws + WS_Y), (const float*)(ws + WS_STATS)};
            gemm_phase(tid, lds, S, E, DM, DM, 16);
        } break;
        default: {
            norm_rows<true>(tid, bx, G, xres, p.in[11], MOD + 24576, 0, 1024, nullptr, xres);
        } break;
        }
        if (ph + 1 < p.ph_hi) cg::this_grid().sync();
    }
}
constexpr int N_PHASES = 2 + 2 * (1 + 3 + 3) + 2 * (1 + 10 + 3) + 1;

extern "C" void kernel_launch(void* const* d_in, const int* in_sizes, int n_in, void* d_out, int out_size, void* d_ws, size_t ws_size, hipStream_t stream) {
    static int grid = 0;
    if (grid == 0) {
        if (n_in != 14 || ws_size < WS_END) { fprintf(stderr, "kernel_launch: unexpected n_in %d or ws_size %zu (< %zu)\n", n_in, ws_size, (size_t)WS_END); grid = -1; return; }
        int dev = 0, cus = 0, per_cu = 0;
        hipGetDevice(&dev); hipDeviceGetAttribute(&cus, hipDeviceAttributeMultiprocessorCount, dev);
        if (hipFuncSetAttribute((const void*)mega, hipFuncAttributeMaxDynamicSharedMemorySize, LDS_BYTES) != hipSuccess) { fprintf(stderr, "kernel_launch: hipFuncSetAttribute failed\n"); grid = -1; return; }
        hipOccupancyMaxActiveBlocksPerMultiprocessor(&per_cu, (const void*)mega, 512, LDS_BYTES);
        (void)hipGetLastError();
        if (per_cu < 1) { fprintf(stderr, "kernel_launch: occupancy query says %d blocks per CU\n", per_cu); per_cu = 1; }
        grid = cus;
    }
    if (grid < 0) return;
    Params p{};
    for (int i = 0; i < 14; ++i) p.in[i] = (const float*)d_in[i];
    p.out = (float*)d_out; p.ws = (unsigned char*)d_ws;
#if MULTI_LAUNCH
    for (int k = 0; k < N_PHASES; ++k) { p.ph_lo = k; p.ph_hi = k + 1; hipLaunchKernelGGL(mega, dim3(grid), dim3(512), LDS_BYTES, stream, p); }
#else
    p.ph_lo = 0; p.ph_hi = N_PHASES;
    void* args[] = {&p};
    hipError_t e = hipLaunchCooperativeKernel((const void*)mega, dim3(grid), dim3(512), args, LDS_BYTES, stream);
    if (e != hipSuccess) fprintf(stderr, "cooperative launch failed: %s (grid %d)\n", hipGetErrorString(e), grid);
#endif
}
```

```cpp
#include <hip/hip_runtime.h>
#include <hip/hip_cooperative_groups.h>
#include <cstdio>
namespace cg = cooperative_groups;

#ifndef MULTI_LAUNCH
#define MULTI_LAUNCH 0
#endif
#ifndef PROBE_NDUP
#define PROBE_NDUP 0
#define PROBE_DUPS 0
#endif

#define LAS __attribute__((address_space(3)))
typedef unsigned short bf16_t;
typedef short bf16x8 __attribute__((ext_vector_type(8)));
typedef float f32x4 __attribute__((ext_vector_type(4)));
typedef float f32x2 __attribute__((ext_vector_type(2)));
typedef unsigned u32x4 __attribute__((ext_vector_type(4)));
typedef unsigned u32x2 __attribute__((ext_vector_type(2)));

constexpr int NTOK = 32768, SEQ = 4096, DM = 1024, DFF = 2816, HTOK = 16384;
constexpr int BM = 256, BK = 64, HALF = 128, HTB = HALF * BK * 2, STAGE_BYTES = 8 * HTB, NXCD = 8, WGM = 8;
constexpr int MODW = 26624;
constexpr int LDS_BYTES = STAGE_BYTES + 1024;
constexpr size_t MiB = 1048576;
constexpr size_t WS_MOD = 0, WS_ROPE = 1 * MiB, WS_ROPET = 5 * MiB, WS_CS = 9 * MiB, WS_STATS = 10 * MiB;
constexpr size_t WS_W = 14 * MiB;
constexpr size_t W_MIXIN = WS_W, W_MIXOUT = WS_W + 12 * MiB, W_FFNIN = WS_W + 16 * MiB, W_FFNOUT = WS_W + 27 * MiB;
constexpr size_t WS_H = 47 * MiB;
constexpr size_t WS_BIG = 111 * MiB;
constexpr size_t WS_Y1 = WS_BIG, WS_Y2 = WS_BIG + 128 * MiB, WS_FO = WS_BIG + 256 * MiB;
constexpr size_t WS_TA = WS_CS + 256 * 1024, WS_TB = WS_TA + 64 * 1024;
constexpr size_t WS_A2 = WS_BIG, WS_B2 = WS_BIG + 128 * MiB, WS_KTM = WS_BIG + 256 * MiB, WS_KFT = WS_BIG + 288 * MiB, WS_KBT = WS_BIG + 320 * MiB;
constexpr size_t WS_Y = WS_KTM;
constexpr size_t WS_HID = WS_BIG, WS_MODP = WS_BIG;
constexpr size_t WS_END = WS_BIG + 352 * MiB;

__device__ __forceinline__ int lds_byte(int r, int c) { const int st = (r >> 4) * 2 + (c >> 5), rr = r & 15, cc = c & 31, ob = rr * 64 + cc * 2; return st * 1024 + (ob ^ (((ob >> 9) & 1) << 5)); }
__device__ __forceinline__ void stage_rc(int b, int& R, int& C) { const int st = b / 1024, sb = b % 1024, swz = sb ^ (((sb >> 9) & 1) << 5); R = (st >> 1) * 16 + swz / 64; C = (st & 1) * 32 + (swz % 64) / 2; }
__device__ __forceinline__ int perm32(int rho) { const int n = rho >> 4, i = rho & 15; return 8 * (i >> 2) + 4 * n + (i & 3); }
__device__ __forceinline__ unsigned cvt_pk_bf16(float lo, float hi) { unsigned r; asm volatile("v_cvt_pk_bf16_f32 %0, %1, %2" : "=v"(r) : "v"(lo), "v"(hi)); return r; }
__device__ __forceinline__ u32x4 pack8(const f32x4 a, const f32x4 b) { u32x4 w; w.x = cvt_pk_bf16(a[0], a[1]); w.y = cvt_pk_bf16(a[2], a[3]); w.z = cvt_pk_bf16(b[0], b[1]); w.w = cvt_pk_bf16(b[2], b[3]); return w; }
__device__ __forceinline__ float bf_lo(unsigned w) { return __uint_as_float(w << 16); }
__device__ __forceinline__ float bf_hi(unsigned w) { return __uint_as_float(w & 0xffff0000u); }
__device__ __forceinline__ float siluf(float v) { return v / (1.0f + __expf(-v)); }
__device__ __forceinline__ float lg2gamma(int h) { return log2f(1.0f - exp2f(-5.0f - (float)h)); }

struct Unit { unsigned ao, bo; int pm, pn, z; };

struct Order {
    int nM, nN, total, G, c;
    __device__ __forceinline__ void init(int nM_, int nN_, int nz, int G_, int c_) { nM = nM_; nN = nN_; total = nM_ * nN_ * nz; G = G_; c = c_; }
    __device__ __forceinline__ bool get(int i, int& z, int& pm, int& pn) const {
        const int L = i * G + c; if (L >= total) return false;
        int wgid = L; { const int q = total / NXCD, r = total % NXCD, xcd = wgid % NXCD, off = wgid / NXCD; wgid = (xcd < r ? xcd * (q + 1) : r * (q + 1) + (xcd - r) * q) + off; }
        const int per = nM * nN; z = wgid / per; const int w = wgid % per;
        const int nig = WGM * nN, gid = w / nig, fm = gid * WGM, gsz = (nM - fm) < WGM ? (nM - fm) : WGM;
        pm = fm + ((w % nig) % gsz); pn = (w % nig) / gsz; return true;
    }
};
struct GSched {
    Order o; const char* A; const char* B; int n1, n0; unsigned a2, a1, a0, apm, b2, b1, b0, bpn;
    __device__ __forceinline__ const char* baseA() const { return A; }
    __device__ __forceinline__ const char* baseB() const { return B; }
    __device__ __forceinline__ bool next(int i, Unit& u) const {
        int z, pm, pn; if (!o.get(i, z, pm, pn)) return false;
        const int z0 = z % n0, z1 = (z / n0) % n1, z2 = z / (n0 * n1);
        u.z = z; u.pm = pm; u.pn = pn;
        u.ao = z2 * a2 + z1 * a1 + z0 * a0 + pm * apm; u.bo = z2 * b2 + z1 * b1 + z0 * b0 + pn * bpn; return true;
    }
};

template <class Epi, class Sched>
__device__ __forceinline__ void gemm_phase(const int tid, LAS unsigned char* lds, const Sched& S, const Epi& E, const int lda_, const int ldb_, const int nt_) {
    int lda = lda_, ldb = ldb_, nt = nt_; asm volatile("" : "+s"(lda), "+s"(ldb), "+s"(nt));
    const int wid = __builtin_amdgcn_readfirstlane(tid >> 6), lane = tid & 63, wr = wid >> 2, wc = wid & 3, fr = lane & 15, fq = lane >> 4;
    unsigned voffA[2], voffB[2];
#pragma unroll
    for (int i = 0; i < 2; ++i) { int R, C; stage_rc(tid * 16 + i * 8192, R, C); const int Rb = Epi::PERM ? ((R & ~31) + perm32(R & 31)) : R;
        const int Rt = Epi::BMAP ? (64 * (Rb & 63) + (Rb >> 6)) : Rb;
        voffA[i] = (unsigned)(R * lda + C) * 2u; voffB[i] = (unsigned)(Rt * ldb + C) * 2u; }
    const size_t kstep = (size_t)(BK * 2);
    const size_t hstepA = (size_t)HALF * lda * 2, hstepB = (size_t)(Epi::BMAP ? 2 : HALF) * ldb * 2;
    const unsigned ldsw = (unsigned)wid * 1024u;
    const int aoff = lds_byte(wr * 64 + fr, fq * 8), boff = lds_byte(wc * 32 + fr, fq * 8);
#define PG8_SA(b, h) (((b) * 2 + (h)) * HTB)
#define PG8_SB(b, h) ((4 + (b) * 2 + (h)) * HTB)
#define PG8_STAGE(bufoff, gbase, voff) do { _Pragma("unroll") for (int _i = 0; _i < 2; ++_i) \
        __builtin_amdgcn_global_load_lds((const unsigned*)((const char*)(gbase) + (voff)[_i]), (LAS unsigned*)(lds + (bufoff) + ldsw + _i * 8192), 16, 0, 0); } while (0)
#define PG8_LDA(dst, b, h) do { _Pragma("unroll") for (int m = 0; m < 4; ++m) _Pragma("unroll") for (int k = 0; k < 2; ++k) dst[m][k] = *(const LAS bf16x8*)(lds + PG8_SA(b, h) + aoff + m * 2048 + k * 1024); } while (0)
#define PG8_LDB(dst, b, h) do { _Pragma("unroll") for (int n = 0; n < 2; ++n) _Pragma("unroll") for (int k = 0; k < 2; ++k) dst[n][k] = *(const LAS bf16x8*)(lds + PG8_SB(b, h) + boff + n * 2048 + k * 1024); } while (0)
#define PG8_MMA(ai, bj, At, Bt) do { __builtin_amdgcn_s_setprio(1); _Pragma("unroll") for (int m = 0; m < 4; ++m) _Pragma("unroll") for (int n = 0; n < 2; ++n) _Pragma("unroll") for (int k = 0; k < 2; ++k) \
        acc[ai][bj][m][n] = __builtin_amdgcn_mfma_f32_16x16x32_bf16(Bt[n][k], At[m][k], acc[ai][bj][m][n], 0, 0, 0); __builtin_amdgcn_s_setprio(0); } while (0)
#define PG8_WAIT_V(n) asm volatile("s_waitcnt vmcnt(" #n ")" ::: "memory")
#define PG8_WAIT_L(n) asm volatile("s_waitcnt lgkmcnt(" #n ")" ::: "memory")
#define PG8_BAR __builtin_amdgcn_s_barrier()
#define PG8_SCHED __builtin_amdgcn_sched_barrier(0)
    LAS int* ul = (LAS int*)(lds + STAGE_BYTES);
    if (tid < 16) { Unit u; u.ao = 0; u.bo = 0; u.pm = 0; u.pn = 0; u.z = 0; const bool ok = S.next(tid, u);
        ul[tid * 8 + 0] = ok ? 1 : 0; ul[tid * 8 + 1] = (int)u.ao; ul[tid * 8 + 2] = (int)u.bo; ul[tid * 8 + 3] = u.pm; ul[tid * 8 + 4] = u.pn; ul[tid * 8 + 5] = u.z; }
    __syncthreads();
#define PG8_UNIT(i, u, ok) do { const int _i = (i); ok = _i < 16 && __builtin_amdgcn_readfirstlane(ul[(_i & 15) * 8]) != 0; \
        u.ao = (unsigned)__builtin_amdgcn_readfirstlane(ul[(_i & 15) * 8 + 1]); u.bo = (unsigned)__builtin_amdgcn_readfirstlane(ul[(_i & 15) * 8 + 2]); \
        u.pm = __builtin_amdgcn_readfirstlane(ul[(_i & 15) * 8 + 3]); u.pn = __builtin_amdgcn_readfirstlane(ul[(_i & 15) * 8 + 4]); u.z = __builtin_amdgcn_readfirstlane(ul[(_i & 15) * 8 + 5]); } while (0)
    const char* const Abase = S.baseA(); const char* const Bbase = S.baseB();
    Unit cur, nxt; int ui = 0;
    { bool ok0; PG8_UNIT(0, cur, ok0); if (!ok0) return; }
    f32x4 acc[2][2][4][2];
#pragma unroll
    for (int a = 0; a < 2; ++a)
#pragma unroll
        for (int b = 0; b < 2; ++b)
#pragma unroll
            for (int m = 0; m < 4; ++m)
#pragma unroll
                for (int n = 0; n < 2; ++n) acc[a][b][m][n] = (f32x4){0.f, 0.f, 0.f, 0.f};
    bf16x8 At[4][2], B0[2][2], B1[2][2];
    const char* cA = Abase + ((size_t)cur.ao << 8); const char* cB = Bbase + ((size_t)cur.bo << 8);
    PG8_STAGE(PG8_SB(0, 0), cB, voffB); PG8_STAGE(PG8_SA(0, 0), cA, voffA); PG8_STAGE(PG8_SB(0, 1), cB + hstepB, voffB); PG8_STAGE(PG8_SA(0, 1), cA + hstepA, voffA);
    if (wr == 1) PG8_BAR;
    PG8_WAIT_V(4); PG8_BAR;
    PG8_STAGE(PG8_SB(1, 0), cB + kstep, voffB); PG8_STAGE(PG8_SA(1, 0), cA + kstep, voffA); PG8_STAGE(PG8_SB(1, 1), cB + hstepB + kstep, voffB);
    PG8_WAIT_V(6); PG8_BAR;
    for (;;) {
        bool has_next; PG8_UNIT(ui + 1, nxt, has_next);
        const char* nA = has_next ? Abase + ((size_t)nxt.ao << 8) : cA; const char* nB = has_next ? Bbase + ((size_t)nxt.bo << 8) : cB;
        for (int t = 0; t < nt; t += 2) {
            const bool last = (t == nt - 2);
            const char* a1 = cA + (size_t)(t + 1) * kstep;
            const char* a2 = last ? nA : cA + (size_t)(t + 2) * kstep; const char* b2 = last ? nB : cB + (size_t)(t + 2) * kstep;
            const char* a3 = a2 + kstep; const char* b3 = b2 + kstep;
            PG8_LDB(B0, 0, 0); PG8_SCHED; PG8_LDA(At, 0, 0); PG8_STAGE(PG8_SA(1, 1), a1 + hstepA, voffA);
            PG8_WAIT_L(8); PG8_BAR; PG8_WAIT_L(0); PG8_MMA(0, 0, At, B0); PG8_BAR; PG8_SCHED;
            PG8_LDB(B1, 0, 1); PG8_STAGE(PG8_SB(0, 0), b2, voffB);
            PG8_BAR; PG8_WAIT_L(0); PG8_MMA(0, 1, At, B1); PG8_BAR;
            PG8_LDA(At, 0, 1); PG8_STAGE(PG8_SA(0, 0), a2, voffA);
            PG8_BAR; PG8_WAIT_L(0); PG8_MMA(1, 0, At, B0); PG8_BAR; PG8_SCHED;
            PG8_STAGE(PG8_SB(0, 1), b2 + hstepB, voffB);
            PG8_WAIT_V(6); PG8_BAR; PG8_MMA(1, 1, At, B1); PG8_BAR;
            PG8_LDB(B0, 1, 0); PG8_SCHED; PG8_LDA(At, 1, 0); PG8_STAGE(PG8_SA(0, 1), a2 + hstepA, voffA);
            PG8_WAIT_L(8); PG8_BAR; PG8_WAIT_L(0); PG8_MMA(0, 0, At, B0); PG8_BAR; PG8_SCHED;
            PG8_LDB(B1, 1, 1); PG8_STAGE(PG8_SB(1, 0), b3, voffB);
            PG8_BAR; PG8_WAIT_L(0); PG8_MMA(0, 1, At, B1); PG8_BAR;
            PG8_LDA(At, 1, 1); PG8_STAGE(PG8_SA(1, 0), a3, voffA);
            PG8_BAR; PG8_WAIT_L(0); PG8_MMA(1, 0, At, B0); PG8_BAR; PG8_SCHED;
            PG8_STAGE(PG8_SB(1, 1), b3 + hstepB, voffB);
            PG8_WAIT_V(6); PG8_BAR; PG8_MMA(1, 1, At, B1); PG8_BAR;
        }
        E(acc, cur, wr, wc, fr, fq);
        if (!has_next) break;
        if constexpr (!Epi::KEEP_ACC) {
#pragma unroll
            for (int a = 0; a < 2; ++a)
#pragma unroll
                for (int b = 0; b < 2; ++b)
#pragma unroll
                    for (int m = 0; m < 4; ++m)
#pragma unroll
                        for (int n = 0; n < 2; ++n) acc[a][b][m][n] = (f32x4){0.f, 0.f, 0.f, 0.f};
        }
        cur = nxt; cA = nA; cB = nB; ++ui;
    }
    PG8_WAIT_V(0);
    if (wr == 0) PG8_BAR;
    PG8_BAR;
#undef PG8_UNIT
#undef PG8_SA
#undef PG8_SB
#undef PG8_STAGE
#undef PG8_LDA
#undef PG8_LDB
#undef PG8_MMA
#undef PG8_WAIT_V
#undef PG8_WAIT_L
#undef PG8_BAR
#undef PG8_SCHED
}

typedef f32x4 Acc[2][2][4][2];

struct EpiResid {
    static constexpr bool PERM = false, KEEP_ACC = false, BMAP = false;
    const float* base; float* out; const float* gate  ; int row0;
    __device__ __forceinline__ void operator()(Acc& acc, const Unit& u, int wr, int wc, int fr, int fq) const {
        const int rowt = row0 + u.pm * BM, b = rowt / SEQ; const int col0 = u.pn * BM + wc * 32 + 4 * fq;
        f32x4 gv[2][2];
#pragma unroll
        for (int bj = 0; bj < 2; ++bj)
#pragma unroll
            for (int n = 0; n < 2; ++n) gv[bj][n] = *(const f32x4*)(gate + (size_t)b * MODW + col0 + bj * HALF + n * 16);
#pragma unroll
        for (int ai = 0; ai < 2; ++ai)
#pragma unroll
            for (int m = 0; m < 4; ++m) { const size_t off = (size_t)(rowt + ai * HALF + wr * 64 + m * 16 + fr) * DM + col0;
#pragma unroll
                for (int bj = 0; bj < 2; ++bj)
#pragma unroll
                    for (int n = 0; n < 2; ++n) { const f32x4 bs = *(const f32x4*)(base + off + bj * HALF + n * 16);
                        *(f32x4*)(out + off + bj * HALF + n * 16) = bs + gv[bj][n] * acc[ai][bj][m][n]; }
                asm volatile("" ::: "memory"); }
    }
};
struct EpiBf16 {
    static constexpr bool PERM = true, KEEP_ACC = false, BMAP = false;
    bf16_t* O; int ldo; int zrows;
    __device__ __forceinline__ void operator()(Acc& acc, const Unit& u, int wr, int wc, int fr, int fq) const {
        const int row0 = u.z * zrows + u.pm * BM + wr * 64 + fr, col0 = u.pn * BM + wc * 32 + 8 * fq;
#pragma unroll
        for (int ai = 0; ai < 2; ++ai)
#pragma unroll
            for (int m = 0; m < 4; ++m) { bf16_t* rowp = O + (size_t)(row0 + ai * HALF + m * 16) * ldo + col0;
#pragma unroll
                for (int bj = 0; bj < 2; ++bj) *(u32x4*)(rowp + bj * HALF) = pack8(acc[ai][bj][m][0], acc[ai][bj][m][1]); }
    }
};
struct EpiChanDft {
    static constexpr bool PERM = true, KEEP_ACC = false, BMAP = true;
    bf16_t* Y1;
    __device__ __forceinline__ void operator()(Acc& acc, const Unit& u, int wr, int wc, int fr, int fq) const {
        const int b = u.z & 7, g = u.z >> 3;
#pragma unroll
        for (int ai = 0; ai < 2; ++ai)
#pragma unroll
            for (int m = 0; m < 4; ++m) { const int j = ai * HALF + wr * 64 + m * 16 + fr;
#pragma unroll
                for (int bj = 0; bj < 2; ++bj) { const int s2 = 4 * u.pn + 2 * bj + (wc >> 1), s1 = 32 * (wc & 1) + 8 * fq;
                    *(u32x4*)(Y1 + ((((size_t)(b * DM + g * 256 + j) * 64 + s2) * 2 + u.pm) * 64 + s1)) = pack8(acc[ai][bj][m][0], acc[ai][bj][m][1]); } }
    }
};
struct EpiFftA {
    static constexpr bool PERM = true, KEEP_ACC = false, BMAP = false;
    bf16_t* Y2;
    __device__ __forceinline__ void operator()(Acc& acc, const Unit& u, int wr, int wc, int fr, int fq) const {
        const int b = u.pn >> 8;
#pragma unroll
        for (int mm = 0; mm < 2; ++mm) { const int k1 = 32 * wr + 16 * mm + fr;
#pragma unroll
            for (int bj = 0; bj < 2; ++bj) { const int c = ((u.pn * 4) & 1023) + 2 * bj + (wc >> 1), s20 = 32 * (wc & 1) + 8 * fq; f32x4 yr[2], yi[2];
#pragma unroll
                for (int n = 0; n < 2; ++n)
#pragma unroll
                    for (int e = 0; e < 4; ++e) { const float th = (float)(k1 * (s20 + 4 * n + e)) * (1.0f / 4096.0f); const float cs = __builtin_amdgcn_cosf(th), sn = __builtin_amdgcn_sinf(th);
                        const float re = acc[0][bj][2 * mm][n][e], im = acc[0][bj][2 * mm + 1][n][e]; yr[n][e] = re * cs + im * sn; yi[n][e] = im * cs - re * sn; }
                bf16_t* dst = Y2 + ((((size_t)(b * 64 + k1) * DM + c) * 2) * 64 + s20);
                *(u32x4*)(dst) = pack8(yr[0], yr[1]); *(u32x4*)(dst + 64) = pack8(yi[0], yi[1]); } }
    }
};
struct EpiFftB {
    static constexpr bool PERM = true, KEEP_ACC = false, BMAP = false;
    bf16_t* FO;
    __device__ __forceinline__ void operator()(Acc& acc, const Unit& u, int wr, int wc, int fr, int fq) const {
        if (wr != 0) return;
        const int bk = u.pn >> 2, b = bk >> 6, k1 = bk & 63, c0 = (u.pn & 3) * 256 + wc * 32 + 8 * fq;
#pragma unroll
        for (int m = 0; m < 4; ++m) { const int k2 = 16 * m + fr; bf16_t* rowp = FO + (size_t)(b * SEQ + k1 + 64 * k2) * DM + c0;
#pragma unroll
            for (int bj = 0; bj < 2; ++bj) *(u32x4*)(rowp + bj * HALF) = pack8(acc[0][bj][m][0], acc[0][bj][m][1]); }
    }
};
struct EpiSwiglu {
    static constexpr bool PERM = true, KEEP_ACC = false, BMAP = false;
    bf16_t* O;
    __device__ __forceinline__ void operator()(Acc& acc, const Unit& u, int wr, int wc, int fr, int fq) const {
        const int row0 = u.pm * BM + wr * 64 + fr, col0 = u.pn * HALF + wc * 32 + 8 * fq;
#pragma unroll
        for (int ai = 0; ai < 2; ++ai)
#pragma unroll
            for (int m = 0; m < 4; ++m) { f32x4 v0, v1;
#pragma unroll
                for (int e = 0; e < 4; ++e) { v0[e] = siluf(acc[ai][0][m][0][e]) * acc[ai][1][m][0][e]; v1[e] = siluf(acc[ai][0][m][1][e]) * acc[ai][1][m][1][e]; }
                *(u32x4*)(O + (size_t)(row0 + ai * HALF + m * 16) * DFF + col0) = pack8(v0, v1); }
    }
};
struct EpiQK {
    static constexpr bool PERM = true, KEEP_ACC = false, BMAP = false;
    bf16_t* A2; bf16_t* KTM; const float* rope  ;
    __device__ __forceinline__ void operator()(Acc& acc, const Unit& u, int wr, int wc, int fr, int fq) const {
        const bool isq = u.pn < 4; const int h = isq ? u.pn : u.pn - 4; const int i0 = wc * 32 + 8 * fq;
        const float lgf = lg2gamma(h), lgb = lg2gamma(3 - h);
#pragma unroll
        for (int ai = 0; ai < 2; ++ai)
#pragma unroll
            for (int m = 0; m < 4; ++m) {
                const int tl = u.pm * BM + ai * HALF + wr * 64 + m * 16 + fr, s = tl % SEQ, sl = s % 512;
                const f32x4* rp = (const f32x4*)(rope + ((size_t)s * 128 + i0) * 2);
                f32x4 o1[2], o2[2];
#pragma unroll
                for (int n = 0; n < 2; ++n) { const f32x4 r0 = rp[2 * n], r1 = rp[2 * n + 1]; const f32x4 x1 = acc[ai][0][m][n], x2 = acc[ai][1][m][n];
                    const float cs[4] = {r0[0], r0[2], r1[0], r1[2]}, sn[4] = {r0[1], r0[3], r1[1], r1[3]};
#pragma unroll
                    for (int e = 0; e < 4; ++e) { o1[n][e] = x1[e] * cs[e] - x2[e] * sn[e]; o2[n][e] = x1[e] * sn[e] + x2[e] * cs[e]; } }
                if (isq) {
                    const float df = exp2f((float)(sl + 1) * lgf), db = exp2f((float)(512 - sl) * lgb);
                    bf16_t* rowp = A2 + ((size_t)tl * 4 + h) * 1024 + 512 + i0;
                    *(u32x4*)(rowp) = pack8(o1[0] * df, o1[1] * df); *(u32x4*)(rowp + 128) = pack8(o2[0] * df, o2[1] * df);
                    *(u32x4*)(rowp + 256) = pack8(o1[0] * db, o1[1] * db); *(u32x4*)(rowp + 384) = pack8(o2[0] * db, o2[1] * db);
                } else {
                    bf16_t* rowp = KTM + (size_t)tl * 1024 + h * 256 + i0;
                    *(u32x4*)(rowp) = pack8(o1[0] * 0.0625f, o1[1] * 0.0625f); *(u32x4*)(rowp + 128) = pack8(o2[0] * 0.0625f, o2[1] * 0.0625f);
                }
            }
    }
};
struct EpiKVT {
    static constexpr bool PERM = true, KEEP_ACC = false, BMAP = false;
    bf16_t* KFT; bf16_t* KBT; bf16_t* B2; const float* ropet  ;
    __device__ __forceinline__ void operator()(Acc& acc, const Unit& u, int wr, int wc, int fr, int fq) const {
        if (u.pm < 4) {
            const int h = u.pm; const float lgf = lg2gamma(h), lgb = lg2gamma(3 - h);
#pragma unroll
            for (int bj = 0; bj < 2; ++bj) {
                const int tl0 = u.pn * BM + bj * HALF + wc * 32 + 8 * fq, b = tl0 / SEQ, s0 = tl0 % SEQ, sl0 = s0 % 512;
                f32x4 kfd[2], kbd[2];
#pragma unroll
                for (int n = 0; n < 2; ++n)
#pragma unroll
                    for (int e = 0; e < 4; ++e) { const int sl = sl0 + 4 * n + e; kfd[n][e] = 0.0625f * exp2f((float)(511 - sl) * lgf); kbd[n][e] = 0.0625f * exp2f((float)sl * lgb); }
#pragma unroll
                for (int m = 0; m < 4; ++m) {
                    const int i = wr * 64 + m * 16 + fr;
                    const f32x4* rp = (const f32x4*)(ropet + ((size_t)i * SEQ + s0) * 2);
                    f32x4 o1[2], o2[2];
#pragma unroll
                    for (int n = 0; n < 2; ++n) { const f32x4 r0 = rp[2 * n], r1 = rp[2 * n + 1]; const f32x4 x1 = acc[0][bj][m][n], x2 = acc[1][bj][m][n];
                        const float cs[4] = {r0[0], r0[2], r1[0], r1[2]}, sn[4] = {r0[1], r0[3], r1[1], r1[3]};
#pragma unroll
                        for (int e = 0; e < 4; ++e) { o1[n][e] = x1[e] * cs[e] - x2[e] * sn[e]; o2[n][e] = x1[e] * sn[e] + x2[e] * cs[e]; } }
                    const size_t r1off = ((size_t)(b * 4 + h) * 256 + i) * SEQ + s0, r2off = r1off + (size_t)128 * SEQ;
                    *(u32x4*)(KFT + r1off) = pack8(o1[0] * kfd[0], o1[1] * kfd[1]); *(u32x4*)(KFT + r2off) = pack8(o2[0] * kfd[0], o2[1] * kfd[1]);
                    *(u32x4*)(KBT + r1off) = pack8(o1[0] * kbd[0], o1[1] * kbd[1]); *(u32x4*)(KBT + r2off) = pack8(o2[0] * kbd[0], o2[1] * kbd[1]);
                }
            }
        } else {
            const int h = (u.pm - 4) >> 1, dv0 = ((u.pm - 4) & 1) * 256;
#pragma unroll
            for (int bj = 0; bj < 2; ++bj) {
                const int tl0 = u.pn * BM + bj * HALF + wc * 32 + 8 * fq, b = tl0 / SEQ, s0 = tl0 % SEQ, np = s0 / 512, sl0 = s0 % 512;
#pragma unroll
                for (int ai = 0; ai < 2; ++ai)
#pragma unroll
                    for (int m = 0; m < 4; ++m) { const int dv = dv0 + ai * HALF + wr * 64 + m * 16 + fr;
                        *(u32x4*)(B2 + (((size_t)((b * 4 + h) * 8 + np) * 512 + dv) * 1024 + sl0)) = pack8(acc[ai][bj][m][0], acc[ai][bj][m][1]); }
            }
        }
    }
};
struct EpiScores {
    static constexpr bool PERM = true, KEEP_ACC = false, BMAP = false;
    bf16_t* A2;
    __device__ __forceinline__ void operator()(Acc& acc, const Unit& u, int wr, int wc, int fr, int fq) const {
        const int np = u.z % 8, h = (u.z / 8) % 4, b = u.z / 32; const float lgf = lg2gamma(h), lgb = lg2gamma(3 - h);
#pragma unroll
        for (int ai = 0; ai < 2; ++ai)
#pragma unroll
            for (int m = 0; m < 4; ++m) { const int t = u.pm * BM + ai * HALF + wr * 64 + m * 16 + fr; const float tf = -(float)(t + 1) * lgf;
                bf16_t* rowp = A2 + ((size_t)(b * SEQ + np * 512 + t) * 4 + h) * 1024;
#pragma unroll
                for (int bj = 0; bj < 2; ++bj) { const int s0 = u.pn * BM + bj * HALF + wc * 32 + 8 * fq; f32x4 v[2];
#pragma unroll
                    for (int n = 0; n < 2; ++n)
#pragma unroll
                        for (int e = 0; e < 4; ++e) { const int s = s0 + 4 * n + e; const float ex = (s <= t) ? -(float)(s + 1) * lgf : (float)(s - t) * lgb + tf; v[n][e] = acc[ai][bj][m][n][e] * exp2f(ex); }
                    *(u32x4*)(rowp + s0) = pack8(v[0], v[1]); } }
    }
};
struct EpiScan {
    static constexpr bool PERM = true, KEEP_ACC = true, BMAP = false;
    bf16_t* B2; int bh, dir, dvh; float dec;
    __device__ __forceinline__ void operator()(Acc& acc, const Unit& u, int wr, int wc, int fr, int fq) const {
        const int slot = u.z;
        const int col0 = 512 + dir * 256 + wc * 32 + 8 * fq;
#pragma unroll
        for (int ai = 0; ai < 2; ++ai)
#pragma unroll
            for (int m = 0; m < 4; ++m) { const int dv = dvh * 256 + ai * HALF + wr * 64 + m * 16 + fr;
                bf16_t* rowp = B2 + ((size_t)(bh * 8 + slot) * 512 + dv) * 1024 + col0;
#pragma unroll
                for (int bj = 0; bj < 2; ++bj) { *(u32x4*)(rowp + bj * HALF) = pack8(acc[ai][bj][m][0], acc[ai][bj][m][1]);
                    acc[ai][bj][m][0] *= dec; acc[ai][bj][m][1] *= dec; } }
    }
};
struct ScanSched {
    const char* B2; const char* KT; int bh, dir, dvh;
    __device__ __forceinline__ const char* baseA() const { return B2; }
    __device__ __forceinline__ const char* baseB() const { return KT; }
    __device__ __forceinline__ bool next(int i, Unit& u) const {
        if (i >= 7) return false;
        const int ci = dir ? 7 - i : i; u.pm = 0; u.pn = 0; u.z = dir ? ci - 1 : ci + 1;
        u.ao = (unsigned)(((bh * 8 + ci) * 512 + dvh * 256) * 8);
        u.bo = (unsigned)(bh * 256 * 32 + ci * 4);
        return true;
    }
};
struct EpiRetOut {
    static constexpr bool PERM = true, KEEP_ACC = false, BMAP = false;
    bf16_t* Y; float* stats;
    __device__ __forceinline__ void operator()(Acc& acc, const Unit& u, int wr, int wc, int fr, int fq) const {
        const int np = u.z % 8, h = (u.z / 8) % 4, b = u.z / 32;
#pragma unroll
        for (int ai = 0; ai < 2; ++ai)
#pragma unroll
            for (int m = 0; m < 4; ++m) { const int tl = b * SEQ + np * 512 + u.pm * BM + ai * HALF + wr * 64 + m * 16 + fr;
                float s = 0.f, q = 0.f;
#pragma unroll
                for (int bj = 0; bj < 2; ++bj)
#pragma unroll
                    for (int n = 0; n < 2; ++n) { const f32x4 x = acc[ai][bj][m][n]; s += (x[0] + x[1]) + (x[2] + x[3]); q += (x[0] * x[0] + x[1] * x[1]) + (x[2] * x[2] + x[3] * x[3]); }
                s += __shfl_xor(s, 16); s += __shfl_xor(s, 32); q += __shfl_xor(q, 16); q += __shfl_xor(q, 32);
                if (fq == 0) *(f32x2*)(stats + (((size_t)tl * 4 + h) * 8 + u.pn * 4 + wc) * 2) = (f32x2){s, q};
                bf16_t* rowp = Y + (size_t)tl * 2048 + h * 512 + u.pn * BM + wc * 32 + 8 * fq;
#pragma unroll
                for (int bj = 0; bj < 2; ++bj) *(u32x4*)(rowp + bj * HALF) = pack8(acc[ai][bj][m][0], acc[ai][bj][m][1]); }
    }
};
struct EpiGate {
    static constexpr bool PERM = true, KEEP_ACC = false, BMAP = false;
    bf16_t* Y; const float* stats;
    __device__ __forceinline__ void operator()(Acc& acc, const Unit& u, int wr, int wc, int fr, int fq) const {
        const int h = u.pn >> 1;
#pragma unroll
        for (int ai = 0; ai < 2; ++ai)
#pragma unroll
            for (int m = 0; m < 4; ++m) { const int tl = u.pm * BM + ai * HALF + wr * 64 + m * 16 + fr;
                const f32x4* sp = (const f32x4*)(stats + ((size_t)tl * 4 + h) * 16); float s = 0.f, q = 0.f;
#pragma unroll
                for (int k = 0; k < 4; ++k) { const f32x4 v = sp[k]; s += v[0] + v[2]; q += v[1] + v[3]; }
                const float mu = s * (1.0f / 512.0f), var = fmaxf(q * (1.0f / 512.0f) - mu * mu, 0.f), rstd = rsqrtf(var + 1e-6f);
                bf16_t* rowp = Y + (size_t)tl * 2048 + u.pn * BM + wc * 32 + 8 * fq;
#pragma unroll
                for (int bj = 0; bj < 2; ++bj) { const u32x4 yw = *(const u32x4*)(rowp + bj * HALF);
                    const float yv[8] = {bf_lo(yw.x), bf_hi(yw.x), bf_lo(yw.y), bf_hi(yw.y), bf_lo(yw.z), bf_hi(yw.z), bf_lo(yw.w), bf_hi(yw.w)};
                    f32x4 v0, v1;
#pragma unroll
                    for (int e = 0; e < 4; ++e) { v0[e] = siluf(acc[ai][bj][m][0][e]) * (yv[e] - mu) * rstd; v1[e] = siluf(acc[ai][bj][m][1][e]) * (yv[4 + e] - mu) * rstd; }
                    *(u32x4*)(rowp + bj * HALF) = pack8(v0, v1); }
                asm volatile("" ::: "memory"); }
    }
};

template <int MODE>
__device__ __forceinline__ void conv_weight(const int tid, LAS float* tile, const float* W, int K, int N, bf16_t* WT, int tile0, int tstride) {
    const int ntn = N / 64, ntiles = (K / 64) * ntn;
#pragma unroll 1
    for (int t = tile0; t < ntiles; t += tstride) {
        const int k0 = (t / ntn) * 64, n0 = (t % ntn) * 64;
        __syncthreads();
#pragma unroll
        for (int p = 0; p < 2; ++p) { const int kk = p * 32 + (tid >> 4), c4 = (tid & 15) * 4; const f32x4 v = *(const f32x4*)(W + (size_t)(k0 + kk) * N + n0 + c4);
            tile[kk * 65 + c4] = v[0]; tile[kk * 65 + c4 + 1] = v[1]; tile[kk * 65 + c4 + 2] = v[2]; tile[kk * 65 + c4 + 3] = v[3]; }
        __syncthreads();
        const int n = tid >> 3, ks = (tid & 7) * 8; float v[8];
#pragma unroll
        for (int e = 0; e < 8; ++e) v[e] = tile[(ks + e) * 65 + n];
        int nn = n0 + n;
        if (MODE == 1) { const int j = nn < DFF ? nn : nn - DFF; nn = 256 * (j >> 7) + (nn < DFF ? 0 : 128) + (j & 127); }
        u32x4 w; w.x = cvt_pk_bf16(v[0], v[1]); w.y = cvt_pk_bf16(v[2], v[3]); w.z = cvt_pk_bf16(v[4], v[5]); w.w = cvt_pk_bf16(v[6], v[7]);
        *(u32x4*)(WT + (size_t)nn * K + k0 + ks) = w;
    }
}
template <bool FINAL>
__device__ __forceinline__ void norm_rows(const int tid, const int bx, const int G, const float* x, const float* g, const float* mod, int shoff, int scoff, bf16_t* h, float* outf) {
    const int lane = tid & 63, gw = bx * 8 + (tid >> 6), nw = G * 8;
#pragma unroll 2
    for (int r = gw; r < NTOK; r += nw) {
        const int b = r / SEQ; f32x4 v[4]; float ss = 0.f;
#pragma unroll
        for (int j = 0; j < 4; ++j) { v[j] = *(const f32x4*)(x + (size_t)r * DM + j * 256 + lane * 4); ss += (v[j][0] * v[j][0] + v[j][1] * v[j][1]) + (v[j][2] * v[j][2] + v[j][3] * v[j][3]); }
#pragma unroll
        for (int o = 32; o >= 1; o >>= 1) ss += __shfl_xor(ss, o);
        const float rs = rsqrtf(ss * (1.0f / 1024.0f) + 1e-6f);
#pragma unroll
        for (int j = 0; j < 4; ++j) { const int col = j * 256 + lane * 4;
            const f32x4 gg = *(const f32x4*)(g + col), sc = *(const f32x4*)(mod + (size_t)b * MODW + scoff + col), sh = *(const f32x4*)(mod + (size_t)b * MODW + shoff + col);
            const f32x4 y = (v[j] * rs) * gg * (sc + 1.0f) + sh;
            if (FINAL) *(f32x4*)(outf + (size_t)r * DM + col) = y;
            else { u32x2 w; w.x = cvt_pk_bf16(y[0], y[1]); w.y = cvt_pk_bf16(y[2], y[3]); *(u32x2*)(h + (size_t)r * DM + col) = w; } }
    }
}

struct Params { const float* in[14]; float* out; unsigned char* ws; int ph_lo, ph_hi; };

enum { K_GEMV = 0, K_MODFIN, K_PREP, K_F1, K_FA, K_FB, K_N2, K_FF1, K_RESID, K_P1, K_P2S, K_P5, K_GATE, K_FINAL };
enum { R_F3 = 0, R_WOUT, R_FF2 };

__device__ __forceinline__ void plain_sched(GSched& S, int nM, int nN, int G, int c, const void* A, const void* B, int lda, int ldb) {
    S.o.init(nM, nN, 1, G, c); S.A = (const char*)A; S.B = (const char*)B; S.n1 = 1; S.n0 = 1;
    S.a2 = 0; S.a1 = 0; S.a0 = 0; S.apm = (unsigned)(2 * lda); S.b2 = 0; S.b1 = 0; S.b0 = 0; S.bpn = (unsigned)(2 * ldb);
}

__global__ void __launch_bounds__(512, 2) mega(Params p) {
    extern __shared__ __attribute__((aligned(16))) unsigned char shm[];
    for (int pph = p.ph_lo; pph < p.ph_hi; ++pph) {
        int ph = pph;
        if (PROBE_NDUP > 0) { const int dups[] = {PROBE_DUPS}; int sub = 0;
#pragma unroll
            for (int i = 0; i < PROBE_NDUP; ++i) sub += (dups[i] + i + 1 <= pph) ? 1 : 0;
            ph = pph - sub; }
        int tid_ = threadIdx.x, G_ = gridDim.x, bx_ = blockIdx.x; unsigned char* ws_ = p.ws; float* xres_ = p.out; unsigned ldsa = 0;
        asm volatile("" : "+v"(tid_), "+s"(G_), "+s"(bx_), "+s"(ldsa));
        const int tid = tid_, lane = tid & 63, wid = tid >> 6, G = G_, bx = bx_; unsigned char* const ws = ws_; float* const xres = xres_;
        LAS unsigned char* const lds = (LAS unsigned char*)shm + ldsa;
        int kind, l = 0, half = 0, rk = 0;
        if (ph < 2) kind = ph;
        else if (ph == 46) kind = K_FINAL;
        else {
            const int q = ph - 2, pair = q / 22, r = q % 22;
            if (r < 8) { l = 2 * pair; kind = r == 0 ? K_PREP : r == 1 ? K_F1 : r == 2 ? K_FA : r == 3 ? K_FB : r == 4 ? K_RESID : r == 5 ? K_N2 : r == 6 ? K_FF1 : K_RESID; rk = r == 4 ? R_F3 : R_FF2; }
            else { l = 2 * pair + 1; const int r2 = r - 8;
                if (r2 == 0) kind = K_PREP;
                else if (r2 <= 10) { half = (r2 - 1) / 5; const int sub = (r2 - 1) % 5; kind = sub == 0 ? K_P1 : sub == 1 ? K_P2S : sub == 2 ? K_P5 : sub == 3 ? K_GATE : K_RESID; rk = R_WOUT; }
                else { kind = r2 == 11 ? K_N2 : r2 == 12 ? K_FF1 : K_RESID; rk = R_FF2; } }
        }
        float* MOD = (float*)(ws + WS_MOD);
        const float* modl = MOD + l * 6144;
        bf16_t* H = (bf16_t*)(ws + WS_H);
        const float* xcur = l == 0 ? p.in[0] : xres;
        switch (kind) {
        case K_GEMV: {
            const float* c_in = p.in[1]; const float* w_ada = p.in[2]; const float* w_ada_f = p.in[12];
            float* MODP = (float*)(ws + WS_MODP); float* ROPE = (float*)(ws + WS_ROPE); float* ROPET = (float*)(ws + WS_ROPET); bf16_t* CS = (bf16_t*)(ws + WS_CS);
            LAS float* cact = (LAS float*)lds;
            for (int i = tid; i < 8 * DM; i += 512) { const float v = c_in[i]; cact[i] = v / (1.0f + __expf(-v)); }
            __syncthreads();
            int vz = 0; asm volatile("" : "+v"(vz));
#pragma unroll 1
            for (int w = bx * 8 + wid; w < 104 * 16; w += G * 8) {
                const int cgp = w % 104, ks = w / 104, gc = cgp * 256 + lane * 4;
                const float* Wp; int ldw;
                if (gc < 24576) { const int ll = gc / 6144; Wp = w_ada + (size_t)ll * DM * 6144 + (gc - ll * 6144); ldw = 6144; } else { Wp = w_ada_f + (gc - 24576); ldw = 2048; }
                f32x4 a[8];
#pragma unroll
                for (int b = 0; b < 8; ++b) a[b] = (f32x4){0.f, 0.f, 0.f, 0.f};
#pragma unroll 4
                for (int k = ks * 64; k < ks * 64 + 64; ++k) { const f32x4 wv = *(const f32x4*)(Wp + (size_t)k * ldw);
#pragma unroll
                    for (int b = 0; b < 8; ++b) a[b] += wv * cact[b * DM + k + vz]; }
#pragma unroll
                for (int b = 0; b < 8; ++b) *(f32x4*)(MODP + ((size_t)(ks * 8 + b)) * MODW + gc) = a[b];
            }
#pragma unroll 1
            for (int idx = bx * 512 + tid; idx < SEQ * 128; idx += G * 512) {
                const int s = idx >> 7, i = idx & 127;
                const float invf = exp2f(-(float)i * (13.287712379549449f / 128.0f));
                const float ang = (float)s * invf;
                const double rev = (double)ang * 0.15915494309189535; const float fr_ = (float)(rev - floor(rev));
                const float sn = __builtin_amdgcn_sinf(fr_), cs = __builtin_amdgcn_cosf(fr_);
                *(f32x2*)(ROPE + (size_t)idx * 2) = (f32x2){cs, sn};
                *(f32x2*)(ROPET + ((size_t)i * SEQ + s) * 2) = (f32x2){cs, sn};
            }
#pragma unroll 1
            for (int idx = bx * 512 + tid; idx < 512 * 256; idx += G * 512) {
                const int row = idx >> 8, d = idx & 255, j = row & 255, part = row >> 8; const float fr_ = (float)((j * d) & 255) * (1.0f / 256.0f);
                const float v = (part ? __builtin_amdgcn_sinf(fr_) : __builtin_amdgcn_cosf(fr_)) * 0.0625f;
                CS[idx] = (bf16_t)(cvt_pk_bf16(v, 0.f) & 0xffffu);
            }
            {   bf16_t* TA = (bf16_t*)(ws + WS_TA); bf16_t* TB = (bf16_t*)(ws + WS_TB);
#pragma unroll 1
                for (int idx = bx * 512 + tid; idx < 256 * 128; idx += G * 512) {
                    const int row = idx >> 7, kk = idx & 127, pin = kk >> 6, sx = kk & 63;
                    float va = 0.f, vb = 0.f;
                    if (row < 128) { const int wr_ = row >> 6, m_ = (row >> 4) & 3, fr_ = row & 15, k1 = 32 * wr_ + 16 * (m_ >> 1) + fr_, pout = m_ & 1; const float th = (float)((k1 * sx) & 63) * (1.0f / 64.0f);
                        const float cs = __builtin_amdgcn_cosf(th), sn = __builtin_amdgcn_sinf(th); va = (pout == 0 ? (pin == 0 ? cs : -sn) : (pin == 0 ? -sn : -cs)) * 0.125f; }
                    if (row < 64) { const float th = (float)((row * sx) & 63) * (1.0f / 64.0f); vb = (pin == 0 ? __builtin_amdgcn_cosf(th) : __builtin_amdgcn_sinf(th)) * 0.125f; }
                    TA[idx] = (bf16_t)(cvt_pk_bf16(va, 0.f) & 0xffffu); TB[idx] = (bf16_t)(cvt_pk_bf16(vb, 0.f) & 0xffffu);
                } }
        } break;
        case K_MODFIN: {
            const float* b_ada = p.in[3]; const float* b_ada_f = p.in[13]; const float* MODP = (const float*)(ws + WS_MODP);
#pragma unroll 1
            for (int idx = bx * 512 + tid; idx < 8 * MODW; idx += G * 512) {
                const int b = idx / MODW, gc = idx % MODW; float s = gc < 24576 ? b_ada[gc] : b_ada_f[gc - 24576];
#pragma unroll
                for (int ks = 0; ks < 16; ++ks) s += MODP[((size_t)(ks * 8 + b)) * MODW + gc];
                MOD[idx] = s;
            }
        } break;
        case K_PREP: {
            const bool fourier = (l & 1) == 0; const int j = l >> 1;
            LAS float* tile = (LAS float*)lds;
            if (fourier) {
                conv_weight<0>(tid, tile, p.in[6] + (size_t)j * DM * DM, DM, DM, (bf16_t*)(ws + W_MIXIN), bx, G);
            } else {
                conv_weight<0>(tid, tile, p.in[7] + (size_t)j * DM * 6144, DM, 6144, (bf16_t*)(ws + W_MIXIN), bx, G);
                conv_weight<0>(tid, tile, p.in[8] + (size_t)j * 2048 * DM, 2048, DM, (bf16_t*)(ws + W_MIXOUT), bx, G);
            }
            conv_weight<1>(tid, tile, p.in[9] + (size_t)l * DM * 2 * DFF, DM, 2 * DFF, (bf16_t*)(ws + W_FFNIN), bx, G);
            conv_weight<0>(tid, tile, p.in[10] + (size_t)l * DFF * DM, DFF, DM, (bf16_t*)(ws + W_FFNOUT), bx, G);
            __syncthreads();
            norm_rows<false>(tid, bx, G, xcur, p.in[4] + l * DM, modl, 0, 1024, H, nullptr);
        } break;
        case K_F1: {
            GSched S; S.o.init(2, 16, 32, G, bx); S.A = (const char*)(ws + WS_CS); S.B = (const char*)H; S.n1 = 4; S.n0 = 8;
            S.a2 = 0; S.a1 = 0; S.a0 = 0; S.apm = 2 * 256; S.b2 = 0; S.b1 = 2; S.b0 = SEQ * 8; S.bpn = 4 * 8;
            EpiChanDft E{(bf16_t*)(ws + WS_Y1)};
            gemm_phase(tid, lds, S, E, 256, DM, 4);
        } break;
        case K_FA: {
            GSched S; plain_sched(S, 1, 2048, G, bx, ws + WS_TA, ws + WS_Y1, 128, 128);
            EpiFftA E{(bf16_t*)(ws + WS_Y2)};
            gemm_phase(tid, lds, S, E, 128, 128, 2);
        } break;
        case K_FB: {
            GSched S; plain_sched(S, 1, 2048, G, bx, ws + WS_TB, ws + WS_Y2, 128, 128);
            EpiFftB E{(bf16_t*)(ws + WS_FO)};
            gemm_phase(tid, lds, S, E, 128, 128, 2);
        } break;
        case K_N2: {
            norm_rows<false>(tid, bx, G, xres, p.in[5] + l * DM, modl, 3072, 4096, H, nullptr);
        } break;
        case K_FF1: {
            GSched S; plain_sched(S, 128, 22, G, bx, H, ws + W_FFNIN, DM, DM);
            EpiSwiglu E{(bf16_t*)(ws + WS_HID)};
            gemm_phase(tid, lds, S, E, DM, DM, 16);
        } break;
        case K_RESID: {
            GSched S; EpiResid E; int ld, nt;
            if (rk == R_F3) { ld = DM; nt = 16; plain_sched(S, 128, 4, G, bx, ws + WS_FO, ws + W_MIXIN, ld, ld); E = EpiResid{xcur, xres, modl + 2048, 0}; }
            else if (rk == R_WOUT) { ld = 2048; nt = 32; plain_sched(S, 64, 4, G, bx, ws + WS_Y, ws + W_MIXOUT, ld, ld); E = EpiResid{xres, xres, modl + 2048, half * HTOK}; }
            else { ld = DFF; nt = 44; plain_sched(S, 128, 4, G, bx, ws + WS_HID, ws + W_FFNOUT, ld, ld); E = EpiResid{xres, xres, modl + 5120, 0}; }
            gemm_phase(tid, lds, S, E, ld, ld, nt);
        } break;
        case K_P1: {
            const bf16_t* Hh = H + (size_t)half * HTOK * DM; const bf16_t* WTin = (const bf16_t*)(ws + W_MIXIN);
            { GSched S; plain_sched(S, 64, 8, G, bx, Hh, WTin, DM, DM);
              EpiQK E{(bf16_t*)(ws + WS_A2), (bf16_t*)(ws + WS_KTM), (const float*)(ws + WS_ROPE)};
              gemm_phase(tid, lds, S, E, DM, DM, 16); }
            { GSched S; plain_sched(S, 12, 64, G, bx, WTin + (size_t)1024 * DM, Hh, DM, DM);
              EpiKVT E{(bf16_t*)(ws + WS_KFT), (bf16_t*)(ws + WS_KBT), (bf16_t*)(ws + WS_B2), (const float*)(ws + WS_ROPET)};
              gemm_phase(tid, lds, S, E, DM, DM, 16); }
        } break;
        case K_P2S: {
            bf16_t* A2 = (bf16_t*)(ws + WS_A2); bf16_t* B2 = (bf16_t*)(ws + WS_B2);
            if (bx < 64) {
                const int bh = bx >> 2, dir = (bx >> 1) & 1, dvh = bx & 1, h = bh & 3;
                { unsigned zz = 0; asm volatile("" : "+v"(zz)); const int slot = dir ? 7 : 0;
                  for (int i = tid; i < 256 * 32; i += 512) { const int r = i >> 5, c8 = (i & 31) * 8;
                      *(u32x4*)(B2 + ((size_t)(bh * 8 + slot) * 512 + dvh * 256 + r) * 1024 + 512 + dir * 256 + c8) = (u32x4){zz, zz, zz, zz}; } }
                ScanSched S{(const char*)B2, (const char*)(ws + (dir ? WS_KBT : WS_KFT)), bh, dir, dvh};
                EpiScan E{B2, bh, dir, dvh, exp2f(512.0f * lg2gamma(dir ? 3 - h : h))};
                gemm_phase(tid, lds, S, E, 1024, SEQ, 8);
            } else {
                GSched S; S.o.init(2, 2, 128, G - 64, bx - 64); S.A = (const char*)(A2 + 512); S.B = (const char*)(ws + WS_KTM); S.n1 = 4; S.n0 = 8;
                S.a2 = SEQ * 32; S.a1 = 8; S.a0 = 512 * 32; S.apm = 256 * 32;
                S.b2 = SEQ * 8; S.b1 = 2; S.b0 = 512 * 8; S.bpn = 256 * 8;
                EpiScores E{A2};
                gemm_phase(tid, lds, S, E, 4096, DM, 4);
            }
        } break;
        case K_P5: {
            GSched S; S.o.init(2, 2, 128, G, bx); S.A = (const char*)(ws + WS_A2); S.B = (const char*)(ws + WS_B2); S.n1 = 4; S.n0 = 8;
            S.a2 = SEQ * 32; S.a1 = 8; S.a0 = 512 * 32; S.apm = 256 * 32;
            S.b2 = 32 * 512 * 8; S.b1 = 8 * 512 * 8; S.b0 = 512 * 8; S.bpn = 256 * 8;
            EpiRetOut E{(bf16_t*)(ws + WS_Y), (float*)(ws + WS_STATS)};
            gemm_phase(tid, lds, S, E, 4096, 1024, 16);
        } break;
        case K_GATE: {
            GSched S; plain_sched(S, 64, 8, G, bx, H + (size_t)half * HTOK * DM, (const bf16_t*)(ws + W_MIXIN) + (size_t)4096 * DM, DM, DM);
            EpiGate E{(bf16_t*)(ws + WS_Y), (const float*)(ws + WS_STATS)};
            gemm_phase(tid, lds, S, E, DM, DM, 16);
        } break;
        default: {
            norm_rows<true>(tid, bx, G, xres, p.in[11], MOD + 24576, 0, 1024, nullptr, xres);
        } break;
        }
        if (pph + 1 < p.ph_hi) cg::this_grid().sync();
    }
}
constexpr int N_PHASES = 2 + 2 * (1 + 4 + 3) + 2 * (1 + 10 + 3) + 1 + PROBE_NDUP;

extern "C" void kernel_launch(void* const* d_in, const int* in_sizes, int n_in, void* d_out, int out_size, void* d_ws, size_t ws_size, hipStream_t stream) {
    static int grid = 0;
    if (grid == 0) {
        if (n_in != 14 || ws_size < WS_END) { fprintf(stderr, "kernel_launch: unexpected n_in %d or ws_size %zu (< %zu)\n", n_in, ws_size, (size_t)WS_END); grid = -1; return; }
        int dev = 0, cus = 0, per_cu = 0;
        hipGetDevice(&dev); hipDeviceGetAttribute(&cus, hipDeviceAttributeMultiprocessorCount, dev);
        if (hipFuncSetAttribute((const void*)mega, hipFuncAttributeMaxDynamicSharedMemorySize, LDS_BYTES) != hipSuccess) { fprintf(stderr, "kernel_launch: hipFuncSetAttribute failed\n"); grid = -1; return; }
        hipOccupancyMaxActiveBlocksPerMultiprocessor(&per_cu, (const void*)mega, 512, LDS_BYTES);
        (void)hipGetLastError();
        if (per_cu < 1) { fprintf(stderr, "kernel_launch: occupancy query says %d blocks per CU\n", per_cu); per_cu = 1; }
        grid = cus;
    }
    if (grid < 0) return;
    Params p{};
    for (int i = 0; i < 14; ++i) p.in[i] = (const float*)d_in[i];
    p.out = (float*)d_out; p.ws = (unsigned char*)d_ws;
#if MULTI_LAUNCH
    for (int k = 0; k < N_PHASES; ++k) { p.ph_lo = k; p.ph_hi = k + 1; hipLaunchKernelGGL(mega, dim3(grid), dim3(512), LDS_BYTES, stream, p); }
#else
    p.ph_lo = 0; p.ph_hi = N_PHASES;
    void* args[] = {&p};
    hipError_t e = hipLaunchCooperativeKernel((const void*)mega, dim3(grid), dim3(512), args, LDS_BYTES, stream);
    if (e != hipSuccess) fprintf(stderr, "cooperative launch failed: %s (grid %d)\n", hipGetErrorString(e), grid);
#endif
}
```

```cpp
#include <hip/hip_runtime.h>
#include <hip/hip_cooperative_groups.h>
#include <cstdio>
namespace cg = cooperative_groups;

#ifndef MULTI_LAUNCH
#define MULTI_LAUNCH 0
#endif
#ifndef PROBE_NDUP
#define PROBE_NDUP 0
#define PROBE_DUPS 0
#endif

#define LAS __attribute__((address_space(3)))
typedef unsigned short bf16_t;
typedef short bf16x8 __attribute__((ext_vector_type(8)));
typedef float f32x4 __attribute__((ext_vector_type(4)));
typedef float f32x2 __attribute__((ext_vector_type(2)));
typedef unsigned u32x4 __attribute__((ext_vector_type(4)));
typedef unsigned u32x2 __attribute__((ext_vector_type(2)));

constexpr int NTOK = 32768, SEQ = 4096, DM = 1024, DFF = 2816, HTOK = 16384;
constexpr int BM = 256, BK = 64, HALF = 128, HTB = HALF * BK * 2, STAGE_BYTES = 8 * HTB, NXCD = 8, WGM = 8;
constexpr int MODW = 26624;
constexpr int LDS_BYTES = STAGE_BYTES + 1024;
constexpr size_t MiB = 1048576;
constexpr size_t WS_MOD = 0, WS_ROPE = 1 * MiB, WS_ROPET = 5 * MiB, WS_CS = 9 * MiB, WS_STATS = 10 * MiB;
constexpr size_t WS_BAR = 900 * 1024;
constexpr size_t WS_W = 14 * MiB;
constexpr size_t W_MIXIN = WS_W, W_MIXOUT = WS_W + 12 * MiB, W_FFNIN = WS_W + 16 * MiB, W_FFNOUT = WS_W + 27 * MiB;
constexpr size_t WS_H = 47 * MiB;
constexpr size_t WS_BIG = 111 * MiB;
constexpr size_t WS_Y1 = WS_BIG, WS_Y2 = WS_BIG + 128 * MiB, WS_FO = WS_BIG + 256 * MiB;
constexpr size_t WS_TA = WS_CS + 256 * 1024, WS_TB = WS_TA + 64 * 1024;
constexpr size_t WS_A2 = WS_BIG, WS_B2 = WS_BIG + 128 * MiB, WS_KTM = WS_BIG + 256 * MiB, WS_KFT = WS_BIG + 288 * MiB, WS_KBT = WS_BIG + 320 * MiB;
constexpr size_t WS_Y = WS_KTM;
constexpr size_t WS_HID = WS_BIG, WS_MODP = WS_BIG;
constexpr size_t WS_END = WS_BIG + 352 * MiB;

__device__ __forceinline__ int lds_byte(int r, int c) { const int st = (r >> 4) * 2 + (c >> 5), rr = r & 15, cc = c & 31, ob = rr * 64 + cc * 2; return st * 1024 + (ob ^ (((ob >> 9) & 1) << 5)); }
__device__ __forceinline__ void stage_rc(int b, int& R, int& C) { const int st = b / 1024, sb = b % 1024, swz = sb ^ (((sb >> 9) & 1) << 5); R = (st >> 1) * 16 + swz / 64; C = (st & 1) * 32 + (swz % 64) / 2; }
__device__ __forceinline__ int perm32(int rho) { const int n = rho >> 4, i = rho & 15; return 8 * (i >> 2) + 4 * n + (i & 3); }
__device__ __forceinline__ unsigned cvt_pk_bf16(float lo, float hi) { unsigned r; asm volatile("v_cvt_pk_bf16_f32 %0, %1, %2" : "=v"(r) : "v"(lo), "v"(hi)); return r; }
__device__ __forceinline__ u32x4 pack8(const f32x4 a, const f32x4 b) { u32x4 w; w.x = cvt_pk_bf16(a[0], a[1]); w.y = cvt_pk_bf16(a[2], a[3]); w.z = cvt_pk_bf16(b[0], b[1]); w.w = cvt_pk_bf16(b[2], b[3]); return w; }
__device__ __forceinline__ float bf_lo(unsigned w) { return __uint_as_float(w << 16); }
__device__ __forceinline__ float bf_hi(unsigned w) { return __uint_as_float(w & 0xffff0000u); }
__device__ __forceinline__ float siluf(float v) { return v / (1.0f + __expf(-v)); }
__device__ __forceinline__ float lg2gamma(int h) { return log2f(1.0f - exp2f(-5.0f - (float)h)); }

struct Unit { unsigned ao, bo; int pm, pn, z; };

struct Order {
    int nM, nN, total, G, c;
    __device__ __forceinline__ void init(int nM_, int nN_, int nz, int G_, int c_) { nM = nM_; nN = nN_; total = nM_ * nN_ * nz; G = G_; c = c_; }
    __device__ __forceinline__ bool get(int i, int& z, int& pm, int& pn) const {
        const int L = i * G + c; if (L >= total) return false;
        int wgid = L; { const int q = total / NXCD, r = total % NXCD, xcd = wgid % NXCD, off = wgid / NXCD; wgid = (xcd < r ? xcd * (q + 1) : r * (q + 1) + (xcd - r) * q) + off; }
        const int per = nM * nN; z = wgid / per; const int w = wgid % per;
        const int nig = WGM * nN, gid = w / nig, fm = gid * WGM, gsz = (nM - fm) < WGM ? (nM - fm) : WGM;
        pm = fm + ((w % nig) % gsz); pn = (w % nig) / gsz; return true;
    }
};
struct GSched {
    Order o; const char* A; const char* B; int n1, n0; unsigned a2, a1, a0, apm, b2, b1, b0, bpn;
    __device__ __forceinline__ const char* baseA() const { return A; }
    __device__ __forceinline__ const char* baseB() const { return B; }
    __device__ __forceinline__ bool next(int i, Unit& u) const {
        int z, pm, pn; if (!o.get(i, z, pm, pn)) return false;
        const int z0 = z % n0, z1 = (z / n0) % n1, z2 = z / (n0 * n1);
        u.z = z; u.pm = pm; u.pn = pn;
        u.ao = z2 * a2 + z1 * a1 + z0 * a0 + pm * apm; u.bo = z2 * b2 + z1 * b1 + z0 * b0 + pn * bpn; return true;
    }
};

template <class Epi, class Sched>
__device__ __forceinline__ void gemm_phase(const int tid, LAS unsigned char* lds, const Sched& S, const Epi& E, const int lda_, const int ldb_, const int nt_) {
    int lda = lda_, ldb = ldb_, nt = nt_; asm volatile("" : "+s"(lda), "+s"(ldb), "+s"(nt));
    const int wid = __builtin_amdgcn_readfirstlane(tid >> 6), lane = tid & 63, wr = wid >> 2, wc = wid & 3, fr = lane & 15, fq = lane >> 4;
    unsigned voffA[2], voffB[2];
#pragma unroll
    for (int i = 0; i < 2; ++i) { int R, C; stage_rc(tid * 16 + i * 8192, R, C); const int Rb = Epi::PERM ? ((R & ~31) + perm32(R & 31)) : R;
        const int Rt = Epi::BMAP ? (64 * (Rb & 63) + (Rb >> 6)) : Rb;
        voffA[i] = (unsigned)(R * lda + C) * 2u; voffB[i] = (unsigned)(Rt * ldb + C) * 2u; }
    const size_t kstep = (size_t)(BK * 2);
    const size_t hstepA = (size_t)HALF * lda * 2, hstepB = (size_t)(Epi::BMAP ? 2 : HALF) * ldb * 2;
    const unsigned ldsw = (unsigned)wid * 1024u;
    const int aoff = lds_byte(wr * 64 + fr, fq * 8), boff = lds_byte(wc * 32 + fr, fq * 8);
#define PG8_SA(b, h) (((b) * 2 + (h)) * HTB)
#define PG8_SB(b, h) ((4 + (b) * 2 + (h)) * HTB)
#define PG8_STAGE(bufoff, gbase, voff) do { _Pragma("unroll") for (int _i = 0; _i < 2; ++_i) \
        __builtin_amdgcn_global_load_lds((const unsigned*)((const char*)(gbase) + (voff)[_i]), (LAS unsigned*)(lds + (bufoff) + ldsw + _i * 8192), 16, 0, 0); } while (0)
#define PG8_LDA(dst, b, h) do { _Pragma("unroll") for (int m = 0; m < 4; ++m) _Pragma("unroll") for (int k = 0; k < 2; ++k) dst[m][k] = *(const LAS bf16x8*)(lds + PG8_SA(b, h) + aoff + m * 2048 + k * 1024); } while (0)
#define PG8_LDB(dst, b, h) do { _Pragma("unroll") for (int n = 0; n < 2; ++n) _Pragma("unroll") for (int k = 0; k < 2; ++k) dst[n][k] = *(const LAS bf16x8*)(lds + PG8_SB(b, h) + boff + n * 2048 + k * 1024); } while (0)
#define PG8_MMA(ai, bj, At, Bt) do { __builtin_amdgcn_s_setprio(1); _Pragma("unroll") for (int m = 0; m < 4; ++m) _Pragma("unroll") for (int n = 0; n < 2; ++n) _Pragma("unroll") for (int k = 0; k < 2; ++k) \
        acc[ai][bj][m][n] = __builtin_amdgcn_mfma_f32_16x16x32_bf16(Bt[n][k], At[m][k], acc[ai][bj][m][n], 0, 0, 0); __builtin_amdgcn_s_setprio(0); } while (0)
#define PG8_WAIT_V(n) asm volatile("s_waitcnt vmcnt(" #n ")" ::: "memory")
#define PG8_WAIT_L(n) asm volatile("s_waitcnt lgkmcnt(" #n ")" ::: "memory")
#define PG8_BAR __builtin_amdgcn_s_barrier()
#define PG8_SCHED __builtin_amdgcn_sched_barrier(0)
    LAS int* ul = (LAS int*)(lds + STAGE_BYTES);
    if (tid < 16) { Unit u; u.ao = 0; u.bo = 0; u.pm = 0; u.pn = 0; u.z = 0; const bool ok = S.next(tid, u);
        ul[tid * 8 + 0] = ok ? 1 : 0; ul[tid * 8 + 1] = (int)u.ao; ul[tid * 8 + 2] = (int)u.bo; ul[tid * 8 + 3] = u.pm; ul[tid * 8 + 4] = u.pn; ul[tid * 8 + 5] = u.z; }
    __syncthreads();
#define PG8_UNIT(i, u, ok) do { const int _i = (i); ok = _i < 16 && __builtin_amdgcn_readfirstlane(ul[(_i & 15) * 8]) != 0; \
        u.ao = (unsigned)__builtin_amdgcn_readfirstlane(ul[(_i & 15) * 8 + 1]); u.bo = (unsigned)__builtin_amdgcn_readfirstlane(ul[(_i & 15) * 8 + 2]); \
        u.pm = __builtin_amdgcn_readfirstlane(ul[(_i & 15) * 8 + 3]); u.pn = __builtin_amdgcn_readfirstlane(ul[(_i & 15) * 8 + 4]); u.z = __builtin_amdgcn_readfirstlane(ul[(_i & 15) * 8 + 5]); } while (0)
    const char* const Abase = S.baseA(); const char* const Bbase = S.baseB();
    Unit cur, nxt; int ui = 0;
    { bool ok0; PG8_UNIT(0, cur, ok0); if (!ok0) return; }
    f32x4 acc[2][2][4][2];
#pragma unroll
    for (int a = 0; a < 2; ++a)
#pragma unroll
        for (int b = 0; b < 2; ++b)
#pragma unroll
            for (int m = 0; m < 4; ++m)
#pragma unroll
                for (int n = 0; n < 2; ++n) acc[a][b][m][n] = (f32x4){0.f, 0.f, 0.f, 0.f};
    bf16x8 At[4][2], B0[2][2], B1[2][2];
    const char* cA = Abase + ((size_t)cur.ao << 8); const char* cB = Bbase + ((size_t)cur.bo << 8);
    PG8_STAGE(PG8_SB(0, 0), cB, voffB); PG8_STAGE(PG8_SA(0, 0), cA, voffA); PG8_STAGE(PG8_SB(0, 1), cB + hstepB, voffB); PG8_STAGE(PG8_SA(0, 1), cA + hstepA, voffA);
    if (wr == 1) PG8_BAR;
    PG8_WAIT_V(4); PG8_BAR;
    PG8_STAGE(PG8_SB(1, 0), cB + kstep, voffB); PG8_STAGE(PG8_SA(1, 0), cA + kstep, voffA); PG8_STAGE(PG8_SB(1, 1), cB + hstepB + kstep, voffB);
    PG8_WAIT_V(6); PG8_BAR;
    for (;;) {
        bool has_next; PG8_UNIT(ui + 1, nxt, has_next);
        const char* nA = has_next ? Abase + ((size_t)nxt.ao << 8) : cA; const char* nB = has_next ? Bbase + ((size_t)nxt.bo << 8) : cB;
        for (int t = 0; t < nt; t += 2) {
            const bool last = (t == nt - 2);
            const char* a1 = cA + (size_t)(t + 1) * kstep;
            const char* a2 = last ? nA : cA + (size_t)(t + 2) * kstep; const char* b2 = last ? nB : cB + (size_t)(t + 2) * kstep;
            const char* a3 = a2 + kstep; const char* b3 = b2 + kstep;
            PG8_LDB(B0, 0, 0); PG8_SCHED; PG8_LDA(At, 0, 0); PG8_STAGE(PG8_SA(1, 1), a1 + hstepA, voffA);
            PG8_WAIT_L(8); PG8_BAR; PG8_WAIT_L(0); PG8_MMA(0, 0, At, B0); PG8_BAR; PG8_SCHED;
            PG8_LDB(B1, 0, 1); PG8_STAGE(PG8_SB(0, 0), b2, voffB);
            PG8_BAR; PG8_WAIT_L(0); PG8_MMA(0, 1, At, B1); PG8_BAR;
            PG8_LDA(At, 0, 1); PG8_STAGE(PG8_SA(0, 0), a2, voffA);
            PG8_BAR; PG8_WAIT_L(0); PG8_MMA(1, 0, At, B0); PG8_BAR; PG8_SCHED;
            PG8_STAGE(PG8_SB(0, 1), b2 + hstepB, voffB);
            PG8_WAIT_V(6); PG8_BAR; PG8_MMA(1, 1, At, B1); PG8_BAR;
            PG8_LDB(B0, 1, 0); PG8_SCHED; PG8_LDA(At, 1, 0); PG8_STAGE(PG8_SA(0, 1), a2 + hstepA, voffA);
            PG8_WAIT_L(8); PG8_BAR; PG8_WAIT_L(0); PG8_MMA(0, 0, At, B0); PG8_BAR; PG8_SCHED;
            PG8_LDB(B1, 1, 1); PG8_STAGE(PG8_SB(1, 0), b3, voffB);
            PG8_BAR; PG8_WAIT_L(0); PG8_MMA(0, 1, At, B1); PG8_BAR;
            PG8_LDA(At, 1, 1); PG8_STAGE(PG8_SA(1, 0), a3, voffA);
            PG8_BAR; PG8_WAIT_L(0); PG8_MMA(1, 0, At, B0); PG8_BAR; PG8_SCHED;
            PG8_STAGE(PG8_SB(1, 1), b3 + hstepB, voffB);
            PG8_WAIT_V(6); PG8_BAR; PG8_MMA(1, 1, At, B1); PG8_BAR;
        }
        E(acc, cur, wr, wc, fr, fq);
        if (!has_next) break;
        if constexpr (!Epi::KEEP_ACC) {
#pragma unroll
            for (int a = 0; a < 2; ++a)
#pragma unroll
                for (int b = 0; b < 2; ++b)
#pragma unroll
                    for (int m = 0; m < 4; ++m)
#pragma unroll
                        for (int n = 0; n < 2; ++n) acc[a][b][m][n] = (f32x4){0.f, 0.f, 0.f, 0.f};
        }
        cur = nxt; cA = nA; cB = nB; ++ui;
    }
    PG8_WAIT_V(0);
    if (wr == 0) PG8_BAR;
    PG8_BAR;
#undef PG8_UNIT
#undef PG8_SA
#undef PG8_SB
#undef PG8_STAGE
#undef PG8_LDA
#undef PG8_LDB
#undef PG8_MMA
#undef PG8_WAIT_V
#undef PG8_WAIT_L
#undef PG8_BAR
#undef PG8_SCHED
}

typedef f32x4 Acc[2][2][4][2];

struct EpiResid {
    static constexpr bool PERM = false, KEEP_ACC = false, BMAP = false;
    const float* base; float* out; const float* gate  ; int row0;
    __device__ __forceinline__ void operator()(Acc& acc, const Unit& u, int wr, int wc, int fr, int fq) const {
        const int rowt = row0 + u.pm * BM, b = rowt / SEQ; const int col0 = u.pn * BM + wc * 32 + 4 * fq;
        f32x4 gv[2][2];
#pragma unroll
        for (int bj = 0; bj < 2; ++bj)
#pragma unroll
            for (int n = 0; n < 2; ++n) gv[bj][n] = *(const f32x4*)(gate + (size_t)b * MODW + col0 + bj * HALF + n * 16);
#pragma unroll
        for (int ai = 0; ai < 2; ++ai)
#pragma unroll
            for (int m = 0; m < 4; ++m) { const size_t off = (size_t)(rowt + ai * HALF + wr * 64 + m * 16 + fr) * DM + col0;
#pragma unroll
                for (int bj = 0; bj < 2; ++bj)
#pragma unroll
                    for (int n = 0; n < 2; ++n) { const f32x4 bs = *(const f32x4*)(base + off + bj * HALF + n * 16);
                        *(f32x4*)(out + off + bj * HALF + n * 16) = bs + gv[bj][n] * acc[ai][bj][m][n]; }
                asm volatile("" ::: "memory"); }
    }
};
struct EpiBf16 {
    static constexpr bool PERM = true, KEEP_ACC = false, BMAP = false;
    bf16_t* O; int ldo; int zrows;
    __device__ __forceinline__ void operator()(Acc& acc, const Unit& u, int wr, int wc, int fr, int fq) const {
        const int row0 = u.z * zrows + u.pm * BM + wr * 64 + fr, col0 = u.pn * BM + wc * 32 + 8 * fq;
#pragma unroll
        for (int ai = 0; ai < 2; ++ai)
#pragma unroll
            for (int m = 0; m < 4; ++m) { bf16_t* rowp = O + (size_t)(row0 + ai * HALF + m * 16) * ldo + col0;
#pragma unroll
                for (int bj = 0; bj < 2; ++bj) *(u32x4*)(rowp + bj * HALF) = pack8(acc[ai][bj][m][0], acc[ai][bj][m][1]); }
    }
};
struct EpiChanDft {
    static constexpr bool PERM = true, KEEP_ACC = false, BMAP = true;
    bf16_t* Y1;
    __device__ __forceinline__ void operator()(Acc& acc, const Unit& u, int wr, int wc, int fr, int fq) const {
        const int b = u.z & 7, g = u.z >> 3;
#pragma unroll
        for (int ai = 0; ai < 2; ++ai)
#pragma unroll
            for (int m = 0; m < 4; ++m) { const int j = ai * HALF + wr * 64 + m * 16 + fr;
#pragma unroll
                for (int bj = 0; bj < 2; ++bj) { const int s2 = 4 * u.pn + 2 * bj + (wc >> 1), s1 = 32 * (wc & 1) + 8 * fq;
                    *(u32x4*)(Y1 + ((((size_t)(b * DM + g * 256 + j) * 64 + s2) * 2 + u.pm) * 64 + s1)) = pack8(acc[ai][bj][m][0], acc[ai][bj][m][1]); } }
    }
};
struct EpiFftA {
    static constexpr bool PERM = true, KEEP_ACC = false, BMAP = false;
    bf16_t* Y2;
    __device__ __forceinline__ void operator()(Acc& acc, const Unit& u, int wr, int wc, int fr, int fq) const {
        const int b = u.pn >> 8;
#pragma unroll
        for (int mm = 0; mm < 2; ++mm) { const int k1 = 32 * wr + 16 * mm + fr;
#pragma unroll
            for (int bj = 0; bj < 2; ++bj) { const int c = ((u.pn * 4) & 1023) + 2 * bj + (wc >> 1), s20 = 32 * (wc & 1) + 8 * fq; f32x4 yr[2], yi[2];
#pragma unroll
                for (int n = 0; n < 2; ++n)
#pragma unroll
                    for (int e = 0; e < 4; ++e) { const float th = (float)(k1 * (s20 + 4 * n + e)) * (1.0f / 4096.0f); const float cs = __builtin_amdgcn_cosf(th), sn = __builtin_amdgcn_sinf(th);
                        const float re = acc[0][bj][2 * mm][n][e], im = acc[0][bj][2 * mm + 1][n][e]; yr[n][e] = re * cs + im * sn; yi[n][e] = im * cs - re * sn; }
                bf16_t* dst = Y2 + ((((size_t)(b * 64 + k1) * DM + c) * 2) * 64 + s20);
                *(u32x4*)(dst) = pack8(yr[0], yr[1]); *(u32x4*)(dst + 64) = pack8(yi[0], yi[1]); } }
    }
};
struct EpiFftB {
    static constexpr bool PERM = true, KEEP_ACC = false, BMAP = false;
    bf16_t* FO;
    __device__ __forceinline__ void operator()(Acc& acc, const Unit& u, int wr, int wc, int fr, int fq) const {
        if (wr != 0) return;
        const int bk = u.pn >> 2, b = bk >> 6, k1 = bk & 63, c0 = (u.pn & 3) * 256 + wc * 32 + 8 * fq;
#pragma unroll
        for (int m = 0; m < 4; ++m) { const int k2 = 16 * m + fr; bf16_t* rowp = FO + (size_t)(b * SEQ + k1 + 64 * k2) * DM + c0;
#pragma unroll
            for (int bj = 0; bj < 2; ++bj) *(u32x4*)(rowp + bj * HALF) = pack8(acc[0][bj][m][0], acc[0][bj][m][1]); }
    }
};
struct EpiSwiglu {
    static constexpr bool PERM = true, KEEP_ACC = false, BMAP = false;
    bf16_t* O;
    __device__ __forceinline__ void operator()(Acc& acc, const Unit& u, int wr, int wc, int fr, int fq) const {
        const int row0 = u.pm * BM + wr * 64 + fr, col0 = u.pn * HALF + wc * 32 + 8 * fq;
#pragma unroll
        for (int ai = 0; ai < 2; ++ai)
#pragma unroll
            for (int m = 0; m < 4; ++m) { f32x4 v0, v1;
#pragma unroll
                for (int e = 0; e < 4; ++e) { v0[e] = siluf(acc[ai][0][m][0][e]) * acc[ai][1][m][0][e]; v1[e] = siluf(acc[ai][0][m][1][e]) * acc[ai][1][m][1][e]; }
                *(u32x4*)(O + (size_t)(row0 + ai * HALF + m * 16) * DFF + col0) = pack8(v0, v1); }
    }
};
struct EpiQK {
    static constexpr bool PERM = true, KEEP_ACC = false, BMAP = false;
    bf16_t* A2; bf16_t* KTM; const float* rope  ;
    __device__ __forceinline__ void operator()(Acc& acc, const Unit& u, int wr, int wc, int fr, int fq) const {
        const bool isq = u.pn < 4; const int h = isq ? u.pn : u.pn - 4; const int i0 = wc * 32 + 8 * fq;
        const float lgf = lg2gamma(h), lgb = lg2gamma(3 - h);
#pragma unroll
        for (int ai = 0; ai < 2; ++ai)
#pragma unroll
            for (int m = 0; m < 4; ++m) {
                const int tl = u.pm * BM + ai * HALF + wr * 64 + m * 16 + fr, s = tl % SEQ, sl = s % 512;
                const f32x4* rp = (const f32x4*)(rope + ((size_t)s * 128 + i0) * 2);
                f32x4 o1[2], o2[2];
#pragma unroll
                for (int n = 0; n < 2; ++n) { const f32x4 r0 = rp[2 * n], r1 = rp[2 * n + 1]; const f32x4 x1 = acc[ai][0][m][n], x2 = acc[ai][1][m][n];
                    const float cs[4] = {r0[0], r0[2], r1[0], r1[2]}, sn[4] = {r0[1], r0[3], r1[1], r1[3]};
#pragma unroll
                    for (int e = 0; e < 4; ++e) { o1[n][e] = x1[e] * cs[e] - x2[e] * sn[e]; o2[n][e] = x1[e] * sn[e] + x2[e] * cs[e]; } }
                if (isq) {
                    const float df = exp2f((float)(sl + 1) * lgf), db = exp2f((float)(512 - sl) * lgb);
                    bf16_t* rowp = A2 + ((size_t)tl * 4 + h) * 1024 + 512 + i0;
                    *(u32x4*)(rowp) = pack8(o1[0] * df, o1[1] * df); *(u32x4*)(rowp + 128) = pack8(o2[0] * df, o2[1] * df);
                    *(u32x4*)(rowp + 256) = pack8(o1[0] * db, o1[1] * db); *(u32x4*)(rowp + 384) = pack8(o2[0] * db, o2[1] * db);
                } else {
                    bf16_t* rowp = KTM + (size_t)tl * 1024 + h * 256 + i0;
                    *(u32x4*)(rowp) = pack8(o1[0] * 0.0625f, o1[1] * 0.0625f); *(u32x4*)(rowp + 128) = pack8(o2[0] * 0.0625f, o2[1] * 0.0625f);
                }
            }
    }
};
struct EpiKVT {
    static constexpr bool PERM = true, KEEP_ACC = false, BMAP = false;
    bf16_t* KFT; bf16_t* KBT; bf16_t* B2; const float* ropet  ;
    __device__ __forceinline__ void operator()(Acc& acc, const Unit& u, int wr, int wc, int fr, int fq) const {
        if (u.pm < 4) {
            const int h = u.pm; const float lgf = lg2gamma(h), lgb = lg2gamma(3 - h);
#pragma unroll
            for (int bj = 0; bj < 2; ++bj) {
                const int tl0 = u.pn * BM + bj * HALF + wc * 32 + 8 * fq, b = tl0 / SEQ, s0 = tl0 % SEQ, sl0 = s0 % 512;
                f32x4 kfd[2], kbd[2];
#pragma unroll
                for (int n = 0; n < 2; ++n)
#pragma unroll
                    for (int e = 0; e < 4; ++e) { const int sl = sl0 + 4 * n + e; kfd[n][e] = 0.0625f * exp2f((float)(511 - sl) * lgf); kbd[n][e] = 0.0625f * exp2f((float)sl * lgb); }
#pragma unroll
                for (int m = 0; m < 4; ++m) {
                    const int i = wr * 64 + m * 16 + fr;
                    const f32x4* rp = (const f32x4*)(ropet + ((size_t)i * SEQ + s0) * 2);
                    f32x4 o1[2], o2[2];
#pragma unroll
                    for (int n = 0; n < 2; ++n) { const f32x4 r0 = rp[2 * n], r1 = rp[2 * n + 1]; const f32x4 x1 = acc[0][bj][m][n], x2 = acc[1][bj][m][n];
                        const float cs[4] = {r0[0], r0[2], r1[0], r1[2]}, sn[4] = {r0[1], r0[3], r1[1], r1[3]};
#pragma unroll
                        for (int e = 0; e < 4; ++e) { o1[n][e] = x1[e] * cs[e] - x2[e] * sn[e]; o2[n][e] = x1[e] * sn[e] + x2[e] * cs[e]; } }
                    const size_t r1off = ((size_t)(b * 4 + h) * 256 + i) * SEQ + s0, r2off = r1off + (size_t)128 * SEQ;
                    *(u32x4*)(KFT + r1off) = pack8(o1[0] * kfd[0], o1[1] * kfd[1]); *(u32x4*)(KFT + r2off) = pack8(o2[0] * kfd[0], o2[1] * kfd[1]);
                    *(u32x4*)(KBT + r1off) = pack8(o1[0] * kbd[0], o1[1] * kbd[1]); *(u32x4*)(KBT + r2off) = pack8(o2[0] * kbd[0], o2[1] * kbd[1]);
                }
            }
        } else {
            const int h = (u.pm - 4) >> 1, dv0 = ((u.pm - 4) & 1) * 256;
#pragma unroll
            for (int bj = 0; bj < 2; ++bj) {
                const int tl0 = u.pn * BM + bj * HALF + wc * 32 + 8 * fq, b = tl0 / SEQ, s0 = tl0 % SEQ, np = s0 / 512, sl0 = s0 % 512;
#pragma unroll
                for (int ai = 0; ai < 2; ++ai)
#pragma unroll
                    for (int m = 0; m < 4; ++m) { const int dv = dv0 + ai * HALF + wr * 64 + m * 16 + fr;
                        *(u32x4*)(B2 + (((size_t)((b * 4 + h) * 8 + np) * 512 + dv) * 1024 + sl0)) = pack8(acc[ai][bj][m][0], acc[ai][bj][m][1]); }
            }
        }
    }
};
struct EpiScores {
    static constexpr bool PERM = true, KEEP_ACC = false, BMAP = false;
    bf16_t* A2;
    __device__ __forceinline__ void operator()(Acc& acc, const Unit& u, int wr, int wc, int fr, int fq) const {
        const int np = u.z % 8, h = (u.z / 8) % 4, b = u.z / 32; const float lgf = lg2gamma(h), lgb = lg2gamma(3 - h);
#pragma unroll
        for (int ai = 0; ai < 2; ++ai)
#pragma unroll
            for (int m = 0; m < 4; ++m) { const int t = u.pm * BM + ai * HALF + wr * 64 + m * 16 + fr; const float tf = -(float)(t + 1) * lgf;
                bf16_t* rowp = A2 + ((size_t)(b * SEQ + np * 512 + t) * 4 + h) * 1024;
#pragma unroll
                for (int bj = 0; bj < 2; ++bj) { const int s0 = u.pn * BM + bj * HALF + wc * 32 + 8 * fq; f32x4 v[2];
#pragma unroll
                    for (int n = 0; n < 2; ++n)
#pragma unroll
                        for (int e = 0; e < 4; ++e) { const int s = s0 + 4 * n + e; const float ex = (s <= t) ? -(float)(s + 1) * lgf : (float)(s - t) * lgb + tf; v[n][e] = acc[ai][bj][m][n][e] * exp2f(ex); }
                    *(u32x4*)(rowp + s0) = pack8(v[0], v[1]); } }
    }
};
struct EpiState {
    static constexpr bool PERM = true, KEEP_ACC = false, BMAP = false;
    bf16_t* B2;
    __device__ __forceinline__ void operator()(Acc& acc, const Unit& u, int wr, int wc, int fr, int fq) const {
        const int dvh = u.z & 1, slot = (u.z >> 1) & 7, dir = (u.z >> 4) & 1, bh = u.z >> 5;
        const int col0 = 512 + dir * 256 + wc * 32 + 8 * fq;
#pragma unroll
        for (int ai = 0; ai < 2; ++ai)
#pragma unroll
            for (int m = 0; m < 4; ++m) { const int dv = dvh * 256 + ai * HALF + wr * 64 + m * 16 + fr;
                bf16_t* rowp = B2 + ((size_t)(bh * 8 + slot) * 512 + dv) * 1024 + col0;
#pragma unroll
                for (int bj = 0; bj < 2; ++bj) *(u32x4*)(rowp + bj * HALF) = pack8(acc[ai][bj][m][0], acc[ai][bj][m][1]); }
    }
};
struct StateSched {
    const char* B2; const char* KFT; int G, c;
    __device__ __forceinline__ const char* baseA() const { return B2; }
    __device__ __forceinline__ const char* baseB() const { return KFT; }
    __device__ __forceinline__ bool next(int i, Unit& u) const {
        const int L = i * G + c; if (L >= 448) return false;
        const int dvh = L & 1, t = L >> 1, cidx = t % 7, t2 = t / 7, dir = t2 & 1, bh = t2 >> 1;
        const int ci = dir ? 7 - cidx : cidx, slot = dir ? ci - 1 : ci + 1;
        u.pm = 0; u.pn = 0; u.z = ((bh * 2 + dir) * 8 + slot) * 2 + dvh;
        u.ao = (unsigned)(((bh * 8 + ci) * 512 + dvh * 256) * 8);
        u.bo = (unsigned)(dir * 131072 + bh * 256 * 32 + ci * 4);
        return true;
    }
};
struct EpiRetOut {
    static constexpr bool PERM = true, KEEP_ACC = false, BMAP = false;
    bf16_t* Y; float* stats;
    __device__ __forceinline__ void operator()(Acc& acc, const Unit& u, int wr, int wc, int fr, int fq) const {
        const int np = u.z % 8, h = (u.z / 8) % 4, b = u.z / 32;
#pragma unroll
        for (int ai = 0; ai < 2; ++ai)
#pragma unroll
            for (int m = 0; m < 4; ++m) { const int tl = b * SEQ + np * 512 + u.pm * BM + ai * HALF + wr * 64 + m * 16 + fr;
                float s = 0.f, q = 0.f;
#pragma unroll
                for (int bj = 0; bj < 2; ++bj)
#pragma unroll
                    for (int n = 0; n < 2; ++n) { const f32x4 x = acc[ai][bj][m][n]; s += (x[0] + x[1]) + (x[2] + x[3]); q += (x[0] * x[0] + x[1] * x[1]) + (x[2] * x[2] + x[3] * x[3]); }
                s += __shfl_xor(s, 16); s += __shfl_xor(s, 32); q += __shfl_xor(q, 16); q += __shfl_xor(q, 32);
                if (fq == 0) *(f32x2*)(stats + (((size_t)tl * 4 + h) * 8 + u.pn * 4 + wc) * 2) = (f32x2){s, q};
                bf16_t* rowp = Y + (size_t)tl * 2048 + h * 512 + u.pn * BM + wc * 32 + 8 * fq;
#pragma unroll
                for (int bj = 0; bj < 2; ++bj) *(u32x4*)(rowp + bj * HALF) = pack8(acc[ai][bj][m][0], acc[ai][bj][m][1]); }
    }
};
struct EpiGate {
    static constexpr bool PERM = true, KEEP_ACC = false, BMAP = false;
    bf16_t* Y; const float* stats;
    __device__ __forceinline__ void operator()(Acc& acc, const Unit& u, int wr, int wc, int fr, int fq) const {
        const int h = u.pn >> 1;
#pragma unroll
        for (int ai = 0; ai < 2; ++ai)
#pragma unroll
            for (int m = 0; m < 4; ++m) { const int tl = u.pm * BM + ai * HALF + wr * 64 + m * 16 + fr;
                const f32x4* sp = (const f32x4*)(stats + ((size_t)tl * 4 + h) * 16); float s = 0.f, q = 0.f;
#pragma unroll
                for (int k = 0; k < 4; ++k) { const f32x4 v = sp[k]; s += v[0] + v[2]; q += v[1] + v[3]; }
                const float mu = s * (1.0f / 512.0f), var = fmaxf(q * (1.0f / 512.0f) - mu * mu, 0.f), rstd = rsqrtf(var + 1e-6f);
                bf16_t* rowp = Y + (size_t)tl * 2048 + u.pn * BM + wc * 32 + 8 * fq;
#pragma unroll
                for (int bj = 0; bj < 2; ++bj) { const u32x4 yw = *(const u32x4*)(rowp + bj * HALF);
                    const float yv[8] = {bf_lo(yw.x), bf_hi(yw.x), bf_lo(yw.y), bf_hi(yw.y), bf_lo(yw.z), bf_hi(yw.z), bf_lo(yw.w), bf_hi(yw.w)};
                    f32x4 v0, v1;
#pragma unroll
                    for (int e = 0; e < 4; ++e) { v0[e] = siluf(acc[ai][bj][m][0][e]) * (yv[e] - mu) * rstd; v1[e] = siluf(acc[ai][bj][m][1][e]) * (yv[4 + e] - mu) * rstd; }
                    *(u32x4*)(rowp + bj * HALF) = pack8(v0, v1); }
                asm volatile("" ::: "memory"); }
    }
};

template <int MODE>
__device__ __forceinline__ void conv_weight(const int tid, LAS float* tile, const float* W, int K, int N, bf16_t* WT, int tile0, int tstride) {
    const int ntn = N / 64, ntiles = (K / 64) * ntn;
#pragma unroll 1
    for (int t = tile0; t < ntiles; t += tstride) {
        const int k0 = (t / ntn) * 64, n0 = (t % ntn) * 64;
        __syncthreads();
#pragma unroll
        for (int p = 0; p < 2; ++p) { const int kk = p * 32 + (tid >> 4), c4 = (tid & 15) * 4; const f32x4 v = *(const f32x4*)(W + (size_t)(k0 + kk) * N + n0 + c4);
            tile[kk * 65 + c4] = v[0]; tile[kk * 65 + c4 + 1] = v[1]; tile[kk * 65 + c4 + 2] = v[2]; tile[kk * 65 + c4 + 3] = v[3]; }
        __syncthreads();
        const int n = tid >> 3, ks = (tid & 7) * 8; float v[8];
#pragma unroll
        for (int e = 0; e < 8; ++e) v[e] = tile[(ks + e) * 65 + n];
        int nn = n0 + n;
        if (MODE == 1) { const int j = nn < DFF ? nn : nn - DFF; nn = 256 * (j >> 7) + (nn < DFF ? 0 : 128) + (j & 127); }
        u32x4 w; w.x = cvt_pk_bf16(v[0], v[1]); w.y = cvt_pk_bf16(v[2], v[3]); w.z = cvt_pk_bf16(v[4], v[5]); w.w = cvt_pk_bf16(v[6], v[7]);
        *(u32x4*)(WT + (size_t)nn * K + k0 + ks) = w;
    }
}
template <bool FINAL>
__device__ __forceinline__ void norm_rows(const int tid, const int bx, const int G, const float* x, const float* g, const float* mod, int shoff, int scoff, bf16_t* h, float* outf) {
    const int lane = tid & 63, gw = bx * 8 + (tid >> 6), nw = G * 8;
#pragma unroll 2
    for (int r = gw; r < NTOK; r += nw) {
        const int b = r / SEQ; f32x4 v[4]; float ss = 0.f;
#pragma unroll
        for (int j = 0; j < 4; ++j) { v[j] = *(const f32x4*)(x + (size_t)r * DM + j * 256 + lane * 4); ss += (v[j][0] * v[j][0] + v[j][1] * v[j][1]) + (v[j][2] * v[j][2] + v[j][3] * v[j][3]); }
#pragma unroll
        for (int o = 32; o >= 1; o >>= 1) ss += __shfl_xor(ss, o);
        const float rs = rsqrtf(ss * (1.0f / 1024.0f) + 1e-6f);
#pragma unroll
        for (int j = 0; j < 4; ++j) { const int col = j * 256 + lane * 4;
            const f32x4 gg = *(const f32x4*)(g + col), sc = *(const f32x4*)(mod + (size_t)b * MODW + scoff + col), sh = *(const f32x4*)(mod + (size_t)b * MODW + shoff + col);
            const f32x4 y = (v[j] * rs) * gg * (sc + 1.0f) + sh;
            if (FINAL) *(f32x4*)(outf + (size_t)r * DM + col) = y;
            else { u32x2 w; w.x = cvt_pk_bf16(y[0], y[1]); w.y = cvt_pk_bf16(y[2], y[3]); *(u32x2*)(h + (size_t)r * DM + col) = w; } }
    }
}


#define XB_TMO      128
#define XB_XCNT(j)  (256  + 64 * (j))
#define XB_XSUB(j)  (1280 + 64 * (j))
#define XB_XGEN(j)  (2304 + 64 * (j))
#define XB_TOP      3328
#define XB_TOPGEN   3392
#define XCD_BAR_WORDS 3456
#define XB_SPIN_CAP (1u << 18)
__device__ __forceinline__ unsigned xb_ld(unsigned* p)              { return __hip_atomic_load(p, __ATOMIC_RELAXED, __HIP_MEMORY_SCOPE_AGENT); }
__device__ __forceinline__ unsigned xb_add(unsigned* p, unsigned v) { return __hip_atomic_fetch_add(p, v, __ATOMIC_RELAXED, __HIP_MEMORY_SCOPE_AGENT); }
__device__ __forceinline__ unsigned xb_xcc_id() { return (unsigned)__builtin_amdgcn_s_getreg((3 << 11) | 20) & 0xFu; }
#define XB_SPIN(cond, bar) do { unsigned _sp = 0; while (cond) { __builtin_amdgcn_s_sleep(1); \
    if ((++_sp & 255u) == 0u) { if (xb_ld(&(bar)[XB_TMO])) break; if (_sp > XB_SPIN_CAP) { atomicAdd(&(bar)[XB_TMO], 1u); break; } } } } while (0)
__device__ __forceinline__ void xcd_barrier_complete(unsigned* bar, unsigned x, unsigned& nloc, unsigned& nx) {
    const unsigned G = gridDim.x * gridDim.y * gridDim.z;
    unsigned sum, cnt, mine, sp = 0u;
    for (;;) {
        sum = 0u; cnt = 0u; mine = 0u;
#pragma unroll
        for (unsigned j = 0; j < 16; ++j) { const unsigned c = xb_ld(&bar[XB_XCNT(j)]); sum += c; cnt += (c > 0u) ? 1u : 0u; mine = (j == x) ? c : mine; }
        if (sum == G) break;
        __builtin_amdgcn_s_sleep(1);
        if ((++sp & 255u) == 0u) { if (xb_ld(&bar[XB_TMO])) break; if (sp > XB_SPIN_CAP) { atomicAdd(&bar[XB_TMO], 1u); break; } }
    }
    nloc = mine > 0u ? mine : 1u; nx = cnt > 0u ? cnt : 1u;
}
__device__ __forceinline__ void xcd_barrier(unsigned* bar, volatile LAS unsigned* st, const int tid) {
    asm volatile("s_waitcnt vmcnt(0)" ::: "memory");
    __syncthreads();
    if (tid == 0) {
        const unsigned x = xb_xcc_id();
        __builtin_amdgcn_s_waitcnt(0);
        unsigned nloc = st[0], nx = st[1];
        if (nloc == 0u) { xcd_barrier_complete(bar, x, nloc, nx); st[0] = nloc; st[1] = nx; }
        const unsigned old = xb_add(&bar[XB_XSUB(x)], 1u);
        const unsigned gen = old / nloc;
        if (old + 1u == (gen + 1u) * nloc) {
            __builtin_amdgcn_fence(__ATOMIC_RELEASE, "agent");
            asm volatile("s_waitcnt vmcnt(0)" ::: "memory");
            const unsigned og = xb_add(&bar[XB_TOP], 1u);
            const unsigned tg = og / nx;
            if (og + 1u == (tg + 1u) * nx) xb_add(&bar[XB_TOPGEN], 1u);
            else XB_SPIN(xb_ld(&bar[XB_TOPGEN]) == tg, bar);
            __builtin_amdgcn_fence(__ATOMIC_ACQUIRE, "agent");
            xb_add(&bar[XB_XGEN(x)], 1u);
            asm volatile("s_waitcnt vmcnt(0)" ::: "memory");
        } else {
            XB_SPIN(xb_ld(&bar[XB_XGEN(x)]) == gen, bar);
            __builtin_amdgcn_fence(__ATOMIC_ACQUIRE, "agent");
            asm volatile("s_waitcnt vmcnt(0)" ::: "memory");
        }
    }
    __syncthreads();
}

struct Params { const float* in[14]; float* out; unsigned char* ws; int ph_lo, ph_hi; };

enum { K_GEMV = 0, K_MODFIN, K_PREP, K_F1, K_FA, K_FB, K_N2, K_FF1, K_RESID, K_P1, K_P2S, K_PFX, K_P5, K_GATE, K_FINAL };
enum { R_F3 = 0, R_WOUT, R_FF2 };

__device__ __forceinline__ void plain_sched(GSched& S, int nM, int nN, int G, int c, const void* A, const void* B, int lda, int ldb) {
    S.o.init(nM, nN, 1, G, c); S.A = (const char*)A; S.B = (const char*)B; S.n1 = 1; S.n0 = 1;
    S.a2 = 0; S.a1 = 0; S.a0 = 0; S.apm = (unsigned)(2 * lda); S.b2 = 0; S.b1 = 0; S.b0 = 0; S.bpn = (unsigned)(2 * ldb);
}

__global__ void __launch_bounds__(512, 2) mega(Params p) {
    extern __shared__ __attribute__((aligned(16))) unsigned char shm[];
    {   volatile LAS unsigned* st0 = (volatile LAS unsigned*)((LAS unsigned char*)shm + STAGE_BYTES + 768);
        if (threadIdx.x == 0) { st0[0] = 0u; st0[1] = 0u; (void)xb_add(&((unsigned*)(p.ws + WS_BAR))[XB_XCNT(xb_xcc_id())], 1u); }
        __syncthreads(); }
    for (int pph = p.ph_lo; pph < p.ph_hi; ++pph) {
        int ph = pph;
        if (PROBE_NDUP > 0) { const int dups[] = {PROBE_DUPS}; int sub = 0;
#pragma unroll
            for (int i = 0; i < PROBE_NDUP; ++i) sub += (dups[i] + i + 1 <= pph) ? 1 : 0;
            ph = pph - sub; }
        int tid_ = threadIdx.x, G_ = gridDim.x, bx_ = blockIdx.x; unsigned char* ws_ = p.ws; float* xres_ = p.out; unsigned ldsa = 0;
        asm volatile("" : "+v"(tid_), "+s"(G_), "+s"(bx_), "+s"(ldsa));
        const int tid = tid_, lane = tid & 63, wid = tid >> 6, G = G_, bx = bx_; unsigned char* const ws = ws_; float* const xres = xres_;
        LAS unsigned char* const lds = (LAS unsigned char*)shm + ldsa;
        int kind, l = 0, half = 0, rk = 0;
        if (ph < 2) kind = ph;
        else if (ph == 50) kind = K_FINAL;
        else {
            const int q = ph - 2, pair = q / 24, r = q % 24;
            if (r < 8) { l = 2 * pair; kind = r == 0 ? K_PREP : r == 1 ? K_F1 : r == 2 ? K_FA : r == 3 ? K_FB : r == 4 ? K_RESID : r == 5 ? K_N2 : r == 6 ? K_FF1 : K_RESID; rk = r == 4 ? R_F3 : R_FF2; }
            else { l = 2 * pair + 1; const int r2 = r - 8;
                if (r2 == 0) kind = K_PREP;
                else if (r2 <= 12) { half = (r2 - 1) / 6; const int sub = (r2 - 1) % 6; kind = sub == 0 ? K_P1 : sub == 1 ? K_P2S : sub == 2 ? K_PFX : sub == 3 ? K_P5 : sub == 4 ? K_GATE : K_RESID; rk = R_WOUT; }
                else { kind = r2 == 13 ? K_N2 : r2 == 14 ? K_FF1 : K_RESID; rk = R_FF2; } }
        }
        float* MOD = (float*)(ws + WS_MOD);
        const float* modl = MOD + l * 6144;
        bf16_t* H = (bf16_t*)(ws + WS_H);
        const float* xcur = l == 0 ? p.in[0] : xres;
        switch (kind) {
        case K_GEMV: {
            const float* c_in = p.in[1]; const float* w_ada = p.in[2]; const float* w_ada_f = p.in[12];
            float* MODP = (float*)(ws + WS_MODP); float* ROPE = (float*)(ws + WS_ROPE); float* ROPET = (float*)(ws + WS_ROPET); bf16_t* CS = (bf16_t*)(ws + WS_CS);
            LAS float* cact = (LAS float*)lds;
            for (int i = tid; i < 8 * DM; i += 512) { const float v = c_in[i]; cact[i] = v / (1.0f + __expf(-v)); }
            __syncthreads();
            int vz = 0; asm volatile("" : "+v"(vz));
#pragma unroll 1
            for (int w = bx * 8 + wid; w < 104 * 16; w += G * 8) {
                const int cgp = w % 104, ks = w / 104, gc = cgp * 256 + lane * 4;
                const float* Wp; int ldw;
                if (gc < 24576) { const int ll = gc / 6144; Wp = w_ada + (size_t)ll * DM * 6144 + (gc - ll * 6144); ldw = 6144; } else { Wp = w_ada_f + (gc - 24576); ldw = 2048; }
                f32x4 a[8];
#pragma unroll
                for (int b = 0; b < 8; ++b) a[b] = (f32x4){0.f, 0.f, 0.f, 0.f};
#pragma unroll 4
                for (int k = ks * 64; k < ks * 64 + 64; ++k) { const f32x4 wv = *(const f32x4*)(Wp + (size_t)k * ldw);
#pragma unroll
                    for (int b = 0; b < 8; ++b) a[b] += wv * cact[b * DM + k + vz]; }
#pragma unroll
                for (int b = 0; b < 8; ++b) *(f32x4*)(MODP + ((size_t)(ks * 8 + b)) * MODW + gc) = a[b];
            }
#pragma unroll 1
            for (int idx = bx * 512 + tid; idx < SEQ * 128; idx += G * 512) {
                const int s = idx >> 7, i = idx & 127;
                const float invf = exp2f(-(float)i * (13.287712379549449f / 128.0f));
                const float ang = (float)s * invf;
                const double rev = (double)ang * 0.15915494309189535; const float fr_ = (float)(rev - floor(rev));
                const float sn = __builtin_amdgcn_sinf(fr_), cs = __builtin_amdgcn_cosf(fr_);
                *(f32x2*)(ROPE + (size_t)idx * 2) = (f32x2){cs, sn};
                *(f32x2*)(ROPET + ((size_t)i * SEQ + s) * 2) = (f32x2){cs, sn};
            }
#pragma unroll 1
            for (int idx = bx * 512 + tid; idx < 512 * 256; idx += G * 512) {
                const int row = idx >> 8, d = idx & 255, j = row & 255, part = row >> 8; const float fr_ = (float)((j * d) & 255) * (1.0f / 256.0f);
                const float v = (part ? __builtin_amdgcn_sinf(fr_) : __builtin_amdgcn_cosf(fr_)) * 0.0625f;
                CS[idx] = (bf16_t)(cvt_pk_bf16(v, 0.f) & 0xffffu);
            }
            {   bf16_t* TA = (bf16_t*)(ws + WS_TA); bf16_t* TB = (bf16_t*)(ws + WS_TB);
#pragma unroll 1
                for (int idx = bx * 512 + tid; idx < 256 * 128; idx += G * 512) {
                    const int row = idx >> 7, kk = idx & 127, pin = kk >> 6, sx = kk & 63;
                    float va = 0.f, vb = 0.f;
                    if (row < 128) { const int wr_ = row >> 6, m_ = (row >> 4) & 3, fr_ = row & 15, k1 = 32 * wr_ + 16 * (m_ >> 1) + fr_, pout = m_ & 1; const float th = (float)((k1 * sx) & 63) * (1.0f / 64.0f);
                        const float cs = __builtin_amdgcn_cosf(th), sn = __builtin_amdgcn_sinf(th); va = (pout == 0 ? (pin == 0 ? cs : -sn) : (pin == 0 ? -sn : -cs)) * 0.125f; }
                    if (row < 64) { const float th = (float)((row * sx) & 63) * (1.0f / 64.0f); vb = (pin == 0 ? __builtin_amdgcn_cosf(th) : __builtin_amdgcn_sinf(th)) * 0.125f; }
                    TA[idx] = (bf16_t)(cvt_pk_bf16(va, 0.f) & 0xffffu); TB[idx] = (bf16_t)(cvt_pk_bf16(vb, 0.f) & 0xffffu);
                } }
        } break;
        case K_MODFIN: {
            const float* b_ada = p.in[3]; const float* b_ada_f = p.in[13]; const float* MODP = (const float*)(ws + WS_MODP);
#pragma unroll 1
            for (int idx = bx * 512 + tid; idx < 8 * MODW; idx += G * 512) {
                const int b = idx / MODW, gc = idx % MODW; float s = gc < 24576 ? b_ada[gc] : b_ada_f[gc - 24576];
#pragma unroll
                for (int ks = 0; ks < 16; ++ks) s += MODP[((size_t)(ks * 8 + b)) * MODW + gc];
                MOD[idx] = s;
            }
        } break;
        case K_PREP: {
            const bool fourier = (l & 1) == 0; const int j = l >> 1;
            LAS float* tile = (LAS float*)lds;
            if (fourier) {
                conv_weight<0>(tid, tile, p.in[6] + (size_t)j * DM * DM, DM, DM, (bf16_t*)(ws + W_MIXIN), bx, G);
            } else {
                conv_weight<0>(tid, tile, p.in[7] + (size_t)j * DM * 6144, DM, 6144, (bf16_t*)(ws + W_MIXIN), bx, G);
                conv_weight<0>(tid, tile, p.in[8] + (size_t)j * 2048 * DM, 2048, DM, (bf16_t*)(ws + W_MIXOUT), bx, G);
            }
            conv_weight<1>(tid, tile, p.in[9] + (size_t)l * DM * 2 * DFF, DM, 2 * DFF, (bf16_t*)(ws + W_FFNIN), bx, G);
            conv_weight<0>(tid, tile, p.in[10] + (size_t)l * DFF * DM, DFF, DM, (bf16_t*)(ws + W_FFNOUT), bx, G);
            __syncthreads();
            norm_rows<false>(tid, bx, G, xcur, p.in[4] + l * DM, modl, 0, 1024, H, nullptr);
        } break;
        case K_F1: {
            GSched S; S.o.init(2, 16, 32, G, bx); S.A = (const char*)(ws + WS_CS); S.B = (const char*)H; S.n1 = 4; S.n0 = 8;
            S.a2 = 0; S.a1 = 0; S.a0 = 0; S.apm = 2 * 256; S.b2 = 0; S.b1 = 2; S.b0 = SEQ * 8; S.bpn = 4 * 8;
            EpiChanDft E{(bf16_t*)(ws + WS_Y1)};
            gemm_phase(tid, lds, S, E, 256, DM, 4);
        } break;
        case K_FA: {
            GSched S; plain_sched(S, 1, 2048, G, bx, ws + WS_TA, ws + WS_Y1, 128, 128);
            EpiFftA E{(bf16_t*)(ws + WS_Y2)};
            gemm_phase(tid, lds, S, E, 128, 128, 2);
        } break;
        case K_FB: {
            GSched S; plain_sched(S, 1, 2048, G, bx, ws + WS_TB, ws + WS_Y2, 128, 128);
            EpiFftB E{(bf16_t*)(ws + WS_FO)};
            gemm_phase(tid, lds, S, E, 128, 128, 2);
        } break;
        case K_N2: {
            norm_rows<false>(tid, bx, G, xres, p.in[5] + l * DM, modl, 3072, 4096, H, nullptr);
        } break;
        case K_FF1: {
            GSched S; plain_sched(S, 128, 22, G, bx, H, ws + W_FFNIN, DM, DM);
            EpiSwiglu E{(bf16_t*)(ws + WS_HID)};
            gemm_phase(tid, lds, S, E, DM, DM, 16);
        } break;
        case K_RESID: {
            GSched S; EpiResid E; int ld, nt;
            if (rk == R_F3) { ld = DM; nt = 16; plain_sched(S, 128, 4, G, bx, ws + WS_FO, ws + W_MIXIN, ld, ld); E = EpiResid{xcur, xres, modl + 2048, 0}; }
            else if (rk == R_WOUT) { ld = 2048; nt = 32; plain_sched(S, 64, 4, G, bx, ws + WS_Y, ws + W_MIXOUT, ld, ld); E = EpiResid{xres, xres, modl + 2048, half * HTOK}; }
            else { ld = DFF; nt = 44; plain_sched(S, 128, 4, G, bx, ws + WS_HID, ws + W_FFNOUT, ld, ld); E = EpiResid{xres, xres, modl + 5120, 0}; }
            gemm_phase(tid, lds, S, E, ld, ld, nt);
        } break;
        case K_P1: {
            const bf16_t* Hh = H + (size_t)half * HTOK * DM; const bf16_t* WTin = (const bf16_t*)(ws + W_MIXIN);
            { GSched S; plain_sched(S, 64, 8, G, bx, Hh, WTin, DM, DM);
              EpiQK E{(bf16_t*)(ws + WS_A2), (bf16_t*)(ws + WS_KTM), (const float*)(ws + WS_ROPE)};
              gemm_phase(tid, lds, S, E, DM, DM, 16); }
            { GSched S; plain_sched(S, 12, 64, G, bx, WTin + (size_t)1024 * DM, Hh, DM, DM);
              EpiKVT E{(bf16_t*)(ws + WS_KFT), (bf16_t*)(ws + WS_KBT), (bf16_t*)(ws + WS_B2), (const float*)(ws + WS_ROPET)};
              gemm_phase(tid, lds, S, E, DM, DM, 16); }
        } break;
        case K_P2S: {
            bf16_t* A2 = (bf16_t*)(ws + WS_A2); bf16_t* B2 = (bf16_t*)(ws + WS_B2);
            { StateSched S{(const char*)B2, (const char*)(ws + WS_KFT), G, bx};
              EpiState E{B2};
              gemm_phase(tid, lds, S, E, 1024, SEQ, 8); }
            { GSched S; S.o.init(2, 2, 128, G, G - 1 - bx); S.A = (const char*)(A2 + 512); S.B = (const char*)(ws + WS_KTM); S.n1 = 4; S.n0 = 8;
              S.a2 = SEQ * 32; S.a1 = 8; S.a0 = 512 * 32; S.apm = 256 * 32;
              S.b2 = SEQ * 8; S.b1 = 2; S.b0 = 512 * 8; S.bpn = 256 * 8;
              EpiScores E{A2};
              gemm_phase(tid, lds, S, E, 4096, DM, 4); }
        } break;
        case K_PFX: {
            bf16_t* B2 = (bf16_t*)(ws + WS_B2);
#pragma unroll 1
            for (int it = bx * 512 + tid; it < 16 * 512 * 64; it += G * 512) {
                const int c8 = it & 63, dv = (it >> 6) & 511, bh = it >> 15, dir = c8 >> 5, h = bh & 3;
                const float dec = exp2f(512.0f * lg2gamma(dir ? 3 - h : h));
                bf16_t* p0 = B2 + ((size_t)(bh * 8) * 512 + dv) * 1024 + 512 + c8 * 8;
                float R[8];
#pragma unroll
                for (int e = 0; e < 8; ++e) R[e] = 0.f;
                u32x4 sv[7];
#pragma unroll
                for (int k = 0; k < 7; ++k) { const int slot = dir ? 6 - k : k + 1; sv[k] = *(const u32x4*)(p0 + (size_t)slot * 512 * 1024); }
                *(u32x4*)(p0 + (size_t)(dir ? 7 : 0) * 512 * 1024) = (u32x4){0u, 0u, 0u, 0u};
#pragma unroll
                for (int k = 0; k < 7; ++k) { const int slot = dir ? 6 - k : k + 1; const u32x4 w = sv[k];
                    const float s[8] = {bf_lo(w.x), bf_hi(w.x), bf_lo(w.y), bf_hi(w.y), bf_lo(w.z), bf_hi(w.z), bf_lo(w.w), bf_hi(w.w)};
#pragma unroll
                    for (int e = 0; e < 8; ++e) R[e] = R[e] * dec + s[e];
                    u32x4 o; o.x = cvt_pk_bf16(R[0], R[1]); o.y = cvt_pk_bf16(R[2], R[3]); o.z = cvt_pk_bf16(R[4], R[5]); o.w = cvt_pk_bf16(R[6], R[7]);
                    *(u32x4*)(p0 + (size_t)slot * 512 * 1024) = o; }
            }
        } break;
        case K_P5: {
            GSched S; S.o.init(2, 2, 128, G, bx); S.A = (const char*)(ws + WS_A2); S.B = (const char*)(ws + WS_B2); S.n1 = 4; S.n0 = 8;
            S.a2 = SEQ * 32; S.a1 = 8; S.a0 = 512 * 32; S.apm = 256 * 32;
            S.b2 = 32 * 512 * 8; S.b1 = 8 * 512 * 8; S.b0 = 512 * 8; S.bpn = 256 * 8;
            EpiRetOut E{(bf16_t*)(ws + WS_Y), (float*)(ws + WS_STATS)};
            gemm_phase(tid, lds, S, E, 4096, 1024, 16);
        } break;
        case K_GATE: {
            GSched S; plain_sched(S, 64, 8, G, bx, H + (size_t)half * HTOK * DM, (const bf16_t*)(ws + W_MIXIN) + (size_t)4096 * DM, DM, DM);
            EpiGate E{(bf16_t*)(ws + WS_Y), (const float*)(ws + WS_STATS)};
            gemm_phase(tid, lds, S, E, DM, DM, 16);
        } break;
        default: {
            norm_rows<true>(tid, bx, G, xres, p.in[11], MOD + 24576, 0, 1024, nullptr, xres);
        } break;
        }
        if (pph + 1 < p.ph_hi) {
            if (pph == p.ph_lo) cg::this_grid().sync();
            else xcd_barrier((unsigned*)(ws + WS_BAR), (volatile LAS unsigned*)(lds + STAGE_BYTES + 768), tid);
        }
    }
}
constexpr int N_PHASES = 2 + 2 * (1 + 4 + 3) + 2 * (1 + 12 + 3) + 1 + PROBE_NDUP;

extern "C" void kernel_launch(void* const* d_in, const int* in_sizes, int n_in, void* d_out, int out_size, void* d_ws, size_t ws_size, hipStream_t stream) {
    static int grid = 0;
    if (grid == 0) {
        if (n_in != 14 || ws_size < WS_END) { fprintf(stderr, "kernel_launch: unexpected n_in %d or ws_size %zu (< %zu)\n", n_in, ws_size, (size_t)WS_END); grid = -1; return; }
        int dev = 0, cus = 0, per_cu = 0;
        hipGetDevice(&dev); hipDeviceGetAttribute(&cus, hipDeviceAttributeMultiprocessorCount, dev);
        if (hipFuncSetAttribute((const void*)mega, hipFuncAttributeMaxDynamicSharedMemorySize, LDS_BYTES) != hipSuccess) { fprintf(stderr, "kernel_launch: hipFuncSetAttribute failed\n"); grid = -1; return; }
        hipOccupancyMaxActiveBlocksPerMultiprocessor(&per_cu, (const void*)mega, 512, LDS_BYTES);
        (void)hipGetLastError();
        if (per_cu < 1) { fprintf(stderr, "kernel_launch: occupancy query says %d blocks per CU\n", per_cu); per_cu = 1; }
        grid = cus;
    }
    if (grid < 0) return;
    Params p{};
    for (int i = 0; i < 14; ++i) p.in[i] = (const float*)d_in[i];
    p.out = (float*)d_out; p.ws = (unsigned char*)d_ws;
#if MULTI_LAUNCH
    for (int k = 0; k < N_PHASES; ++k) { p.ph_lo = k; p.ph_hi = k + 1; hipLaunchKernelGGL(mega, dim3(grid), dim3(512), LDS_BYTES, stream, p); }
#else
    p.ph_lo = 0; p.ph_hi = N_PHASES;
    if (hipMemsetAsync((char*)d_ws + WS_BAR, 0, XCD_BAR_WORDS * 4, stream) != hipSuccess) { fprintf(stderr, "kernel_launch: memset of the barrier words failed\n"); return; }
    void* args[] = {&p};
    hipError_t e = hipLaunchCooperativeKernel((const void*)mega, dim3(grid), dim3(512), args, LDS_BYTES, stream);
    if (e != hipSuccess) fprintf(stderr, "cooperative launch failed: %s (grid %d)\n", hipGetErrorString(e), grid);
#endif
}
```

```cpp
#include <hip/hip_runtime.h>
#include <hip/hip_cooperative_groups.h>
#include <cstdio>
namespace cg = cooperative_groups;

#ifndef MULTI_LAUNCH
#define MULTI_LAUNCH 0
#endif
#ifndef PROBE_NDUP
#define PROBE_NDUP 0
#define PROBE_DUPS 0
#endif

#define LAS __attribute__((address_space(3)))
typedef unsigned short bf16_t;
typedef short bf16x8 __attribute__((ext_vector_type(8)));
typedef float f32x4 __attribute__((ext_vector_type(4)));
typedef float f32x2 __attribute__((ext_vector_type(2)));
typedef unsigned u32x4 __attribute__((ext_vector_type(4)));
typedef unsigned u32x2 __attribute__((ext_vector_type(2)));

constexpr int NTOK = 32768, SEQ = 4096, DM = 1024, DFF = 2816, HTOK = 16384;
constexpr int BM = 256, BK = 64, HALF = 128, HTB = HALF * BK * 2, STAGE_BYTES = 8 * HTB, NXCD = 8, WGM = 8;
constexpr int MODW = 26624;
constexpr int LDS_BYTES = STAGE_BYTES + 1024;
constexpr size_t MiB = 1048576;
constexpr size_t WS_MOD = 0, WS_ROPE = 1 * MiB, WS_ROPET = 5 * MiB, WS_CS = 9 * MiB, WS_STATS = 10 * MiB;
constexpr size_t WS_BAR = 900 * 1024;
constexpr size_t WS_W = 14 * MiB;
constexpr size_t W_MIXIN = WS_W, W_MIXOUT = WS_W + 12 * MiB, W_FFNIN = WS_W + 16 * MiB, W_FFNOUT = WS_W + 27 * MiB;
constexpr size_t WS_H = 47 * MiB;
constexpr size_t WS_BIG = 111 * MiB;
constexpr size_t WS_Y1 = WS_BIG, WS_Y2 = WS_BIG + 128 * MiB, WS_FO = WS_BIG + 256 * MiB;
constexpr size_t WS_TA = WS_CS + 256 * 1024, WS_TB = WS_TA + 64 * 1024;
constexpr size_t WS_A2 = WS_BIG, WS_B2 = WS_BIG + 128 * MiB, WS_KTM = WS_BIG + 256 * MiB, WS_KFT = WS_BIG + 288 * MiB, WS_KBT = WS_BIG + 320 * MiB;
constexpr size_t WS_Y = WS_KTM;
constexpr size_t WS_HID = WS_BIG, WS_MODP = WS_BIG;
constexpr size_t WS_END = WS_BIG + 352 * MiB;

__device__ __forceinline__ int lds_byte(int r, int c) { const int st = (r >> 4) * 2 + (c >> 5), rr = r & 15, cc = c & 31, ob = rr * 64 + cc * 2; return st * 1024 + (ob ^ (((ob >> 9) & 1) << 5)); }
__device__ __forceinline__ void stage_rc(int b, int& R, int& C) { const int st = b / 1024, sb = b % 1024, swz = sb ^ (((sb >> 9) & 1) << 5); R = (st >> 1) * 16 + swz / 64; C = (st & 1) * 32 + (swz % 64) / 2; }
__device__ __forceinline__ int perm32(int rho) { const int n = rho >> 4, i = rho & 15; return 8 * (i >> 2) + 4 * n + (i & 3); }
__device__ __forceinline__ unsigned cvt_pk_bf16(float lo, float hi) { unsigned r; asm volatile("v_cvt_pk_bf16_f32 %0, %1, %2" : "=v"(r) : "v"(lo), "v"(hi)); return r; }
__device__ __forceinline__ u32x4 pack8(const f32x4 a, const f32x4 b) { u32x4 w; w.x = cvt_pk_bf16(a[0], a[1]); w.y = cvt_pk_bf16(a[2], a[3]); w.z = cvt_pk_bf16(b[0], b[1]); w.w = cvt_pk_bf16(b[2], b[3]); return w; }
__device__ __forceinline__ float bf_lo(unsigned w) { return __uint_as_float(w << 16); }
__device__ __forceinline__ float bf_hi(unsigned w) { return __uint_as_float(w & 0xffff0000u); }
__device__ __forceinline__ float siluf(float v) { return v * __builtin_amdgcn_rcpf(1.0f + __expf(-v)); }
__device__ __forceinline__ float lg2gamma(int h) { return log2f(1.0f - exp2f(-5.0f - (float)h)); }

struct Unit { unsigned ao, bo; int pm, pn, z; };

struct Order {
    int nM, nN, total, G, c;
    __device__ __forceinline__ void init(int nM_, int nN_, int nz, int G_, int c_) { nM = nM_; nN = nN_; total = nM_ * nN_ * nz; G = G_; c = c_; }
    __device__ __forceinline__ bool get(int i, int& z, int& pm, int& pn) const {
        const int L = i * G + c; if (L >= total) return false;
        int wgid = L; { const int q = total / NXCD, r = total % NXCD, xcd = wgid % NXCD, off = wgid / NXCD; wgid = (xcd < r ? xcd * (q + 1) : r * (q + 1) + (xcd - r) * q) + off; }
        const int per = nM * nN; z = wgid / per; const int w = wgid % per;
        const int nig = WGM * nN, gid = w / nig, fm = gid * WGM, gsz = (nM - fm) < WGM ? (nM - fm) : WGM;
        pm = fm + ((w % nig) % gsz); pn = (w % nig) / gsz; return true;
    }
};
struct GSched {
    Order o; const char* A; const char* B; int n1, n0; unsigned a2, a1, a0, apm, b2, b1, b0, bpn;
    __device__ __forceinline__ const char* baseA() const { return A; }
    __device__ __forceinline__ const char* baseB() const { return B; }
    __device__ __forceinline__ bool next(int i, Unit& u) const {
        int z, pm, pn; if (!o.get(i, z, pm, pn)) return false;
        const int z0 = z % n0, z1 = (z / n0) % n1, z2 = z / (n0 * n1);
        u.z = z; u.pm = pm; u.pn = pn;
        u.ao = z2 * a2 + z1 * a1 + z0 * a0 + pm * apm; u.bo = z2 * b2 + z1 * b1 + z0 * b0 + pn * bpn; return true;
    }
};

template <class Epi, class Sched>
__device__ __forceinline__ void gemm_phase(const int tid, LAS unsigned char* lds, const Sched& S, const Epi& E, const int lda_, const int ldb_, const int nt_) {
    int lda = lda_, ldb = ldb_, nt = nt_; asm volatile("" : "+s"(lda), "+s"(ldb), "+s"(nt));
    const int wid = __builtin_amdgcn_readfirstlane(tid >> 6), lane = tid & 63, wr = wid >> 2, wc = wid & 3, fr = lane & 15, fq = lane >> 4;
    unsigned voffA[2], voffB[2];
#pragma unroll
    for (int i = 0; i < 2; ++i) { int R, C; stage_rc(tid * 16 + i * 8192, R, C); const int Rb = Epi::PERM ? ((R & ~31) + perm32(R & 31)) : R;
        const int Rt = Epi::BMAP ? (64 * (Rb & 63) + (Rb >> 6)) : Rb;
        voffA[i] = (unsigned)(R * lda + C) * 2u; voffB[i] = (unsigned)(Rt * ldb + C) * 2u; }
    const size_t kstep = (size_t)(BK * 2);
    const size_t hstepA = (size_t)HALF * lda * 2, hstepB = (size_t)(Epi::BMAP ? 2 : HALF) * ldb * 2;
    const unsigned ldsw = (unsigned)wid * 1024u;
    const int aoff = lds_byte(wr * 64 + fr, fq * 8), boff = lds_byte(wc * 32 + fr, fq * 8);
#define PG8_SA(b, h) (((b) * 2 + (h)) * HTB)
#define PG8_SB(b, h) ((4 + (b) * 2 + (h)) * HTB)
#define PG8_STAGE(bufoff, gbase, voff) do { _Pragma("unroll") for (int _i = 0; _i < 2; ++_i) \
        __builtin_amdgcn_global_load_lds((const unsigned*)((const char*)(gbase) + (voff)[_i]), (LAS unsigned*)(lds + (bufoff) + ldsw + _i * 8192), 16, 0, 0); } while (0)
#define PG8_LDA(dst, b, h) do { _Pragma("unroll") for (int m = 0; m < 4; ++m) _Pragma("unroll") for (int k = 0; k < 2; ++k) dst[m][k] = *(const LAS bf16x8*)(lds + PG8_SA(b, h) + aoff + m * 2048 + k * 1024); } while (0)
#define PG8_LDB(dst, b, h) do { _Pragma("unroll") for (int n = 0; n < 2; ++n) _Pragma("unroll") for (int k = 0; k < 2; ++k) dst[n][k] = *(const LAS bf16x8*)(lds + PG8_SB(b, h) + boff + n * 2048 + k * 1024); } while (0)
#define PG8_MMA(ai, bj, At, Bt) do { __builtin_amdgcn_s_setprio(1); _Pragma("unroll") for (int m = 0; m < 4; ++m) _Pragma("unroll") for (int n = 0; n < 2; ++n) _Pragma("unroll") for (int k = 0; k < 2; ++k) \
        acc[ai][bj][m][n] = __builtin_amdgcn_mfma_f32_16x16x32_bf16(Bt[n][k], At[m][k], acc[ai][bj][m][n], 0, 0, 0); __builtin_amdgcn_s_setprio(0); } while (0)
#define PG8_WAIT_V(n) asm volatile("s_waitcnt vmcnt(" #n ")" ::: "memory")
#define PG8_WAIT_L(n) asm volatile("s_waitcnt lgkmcnt(" #n ")" ::: "memory")
#define PG8_BAR __builtin_amdgcn_s_barrier()
#define PG8_SCHED __builtin_amdgcn_sched_barrier(0)
    LAS int* ul = (LAS int*)(lds + STAGE_BYTES);
    if (tid < 16) { Unit u; u.ao = 0; u.bo = 0; u.pm = 0; u.pn = 0; u.z = 0; const bool ok = S.next(tid, u);
        ul[tid * 8 + 0] = ok ? 1 : 0; ul[tid * 8 + 1] = (int)u.ao; ul[tid * 8 + 2] = (int)u.bo; ul[tid * 8 + 3] = u.pm; ul[tid * 8 + 4] = u.pn; ul[tid * 8 + 5] = u.z; }
    __syncthreads();
#define PG8_UNIT(i, u, ok) do { const int _i = (i); ok = _i < 16 && __builtin_amdgcn_readfirstlane(ul[(_i & 15) * 8]) != 0; \
        u.ao = (unsigned)__builtin_amdgcn_readfirstlane(ul[(_i & 15) * 8 + 1]); u.bo = (unsigned)__builtin_amdgcn_readfirstlane(ul[(_i & 15) * 8 + 2]); \
        u.pm = __builtin_amdgcn_readfirstlane(ul[(_i & 15) * 8 + 3]); u.pn = __builtin_amdgcn_readfirstlane(ul[(_i & 15) * 8 + 4]); u.z = __builtin_amdgcn_readfirstlane(ul[(_i & 15) * 8 + 5]); } while (0)
    const char* const Abase = S.baseA(); const char* const Bbase = S.baseB();
    Unit cur, nxt; int ui = 0;
    { bool ok0; PG8_UNIT(0, cur, ok0); if (!ok0) return; }
    f32x4 acc[2][2][4][2];
#pragma unroll
    for (int a = 0; a < 2; ++a)
#pragma unroll
        for (int b = 0; b < 2; ++b)
#pragma unroll
            for (int m = 0; m < 4; ++m)
#pragma unroll
                for (int n = 0; n < 2; ++n) acc[a][b][m][n] = (f32x4){0.f, 0.f, 0.f, 0.f};
    bf16x8 At[4][2], B0[2][2], B1[2][2];
    const char* cA = Abase + ((size_t)cur.ao << 8); const char* cB = Bbase + ((size_t)cur.bo << 8);
    PG8_STAGE(PG8_SB(0, 0), cB, voffB); PG8_STAGE(PG8_SA(0, 0), cA, voffA); PG8_STAGE(PG8_SB(0, 1), cB + hstepB, voffB); PG8_STAGE(PG8_SA(0, 1), cA + hstepA, voffA);
    if (wr == 1) PG8_BAR;
    PG8_WAIT_V(4); PG8_BAR;
    PG8_STAGE(PG8_SB(1, 0), cB + kstep, voffB); PG8_STAGE(PG8_SA(1, 0), cA + kstep, voffA); PG8_STAGE(PG8_SB(1, 1), cB + hstepB + kstep, voffB);
    PG8_WAIT_V(6); PG8_BAR;
    for (;;) {
        bool has_next; PG8_UNIT(ui + 1, nxt, has_next);
        const char* nA = has_next ? Abase + ((size_t)nxt.ao << 8) : cA; const char* nB = has_next ? Bbase + ((size_t)nxt.bo << 8) : cB;
        for (int t = 0; t < nt; t += 2) {
            const bool last = (t == nt - 2);
            const char* a1 = cA + (size_t)(t + 1) * kstep;
            const char* a2 = last ? nA : cA + (size_t)(t + 2) * kstep; const char* b2 = last ? nB : cB + (size_t)(t + 2) * kstep;
            const char* a3 = a2 + kstep; const char* b3 = b2 + kstep;
            PG8_LDB(B0, 0, 0); PG8_SCHED; PG8_LDA(At, 0, 0); PG8_STAGE(PG8_SA(1, 1), a1 + hstepA, voffA);
            PG8_WAIT_L(8); PG8_BAR; PG8_WAIT_L(0); PG8_MMA(0, 0, At, B0); PG8_BAR; PG8_SCHED;
            PG8_LDB(B1, 0, 1); PG8_STAGE(PG8_SB(0, 0), b2, voffB);
            PG8_BAR; PG8_WAIT_L(0); PG8_MMA(0, 1, At, B1); PG8_BAR;
            PG8_LDA(At, 0, 1); PG8_STAGE(PG8_SA(0, 0), a2, voffA);
            PG8_BAR; PG8_WAIT_L(0); PG8_MMA(1, 0, At, B0); PG8_BAR; PG8_SCHED;
            PG8_STAGE(PG8_SB(0, 1), b2 + hstepB, voffB);
            PG8_WAIT_V(6); PG8_BAR; PG8_MMA(1, 1, At, B1); PG8_BAR;
            PG8_LDB(B0, 1, 0); PG8_SCHED; PG8_LDA(At, 1, 0); PG8_STAGE(PG8_SA(0, 1), a2 + hstepA, voffA);
            PG8_WAIT_L(8); PG8_BAR; PG8_WAIT_L(0); PG8_MMA(0, 0, At, B0); PG8_BAR; PG8_SCHED;
            PG8_LDB(B1, 1, 1); PG8_STAGE(PG8_SB(1, 0), b3, voffB);
            PG8_BAR; PG8_WAIT_L(0); PG8_MMA(0, 1, At, B1); PG8_BAR;
            PG8_LDA(At, 1, 1); PG8_STAGE(PG8_SA(1, 0), a3, voffA);
            PG8_BAR; PG8_WAIT_L(0); PG8_MMA(1, 0, At, B0); PG8_BAR; PG8_SCHED;
            PG8_STAGE(PG8_SB(1, 1), b3 + hstepB, voffB);
            PG8_WAIT_V(6); PG8_BAR; PG8_MMA(1, 1, At, B1); PG8_BAR;
        }
        E(acc, cur, wr, wc, fr, fq);
        if (!has_next) break;
        if constexpr (!Epi::KEEP_ACC) {
#pragma unroll
            for (int a = 0; a < 2; ++a)
#pragma unroll
                for (int b = 0; b < 2; ++b)
#pragma unroll
                    for (int m = 0; m < 4; ++m)
#pragma unroll
                        for (int n = 0; n < 2; ++n) acc[a][b][m][n] = (f32x4){0.f, 0.f, 0.f, 0.f};
        }
        cur = nxt; cA = nA; cB = nB; ++ui;
    }
    PG8_WAIT_V(0);
    if (wr == 0) PG8_BAR;
    PG8_BAR;
#undef PG8_UNIT
#undef PG8_SA
#undef PG8_SB
#undef PG8_STAGE
#undef PG8_LDA
#undef PG8_LDB
#undef PG8_MMA
#undef PG8_WAIT_V
#undef PG8_WAIT_L
#undef PG8_BAR
#undef PG8_SCHED
}

typedef f32x4 Acc[2][2][4][2];

struct EpiResid {
    static constexpr bool PERM = true, KEEP_ACC = false, BMAP = false;
    const float* base32; const bf16_t* base16; bf16_t* out; const float* gate  ; int row0;
    __device__ __forceinline__ void operator()(Acc& acc, const Unit& u, int wr, int wc, int fr, int fq) const {
        const int rowt = row0 + u.pm * BM, b = rowt / SEQ; const int col0 = u.pn * BM + wc * 32 + 8 * fq;
        f32x4 gv[2][2];
#pragma unroll
        for (int bj = 0; bj < 2; ++bj)
#pragma unroll
            for (int n = 0; n < 2; ++n) gv[bj][n] = *(const f32x4*)(gate + (size_t)b * MODW + col0 + bj * HALF + 4 * n);
        if (base32) {
#pragma unroll
            for (int ai = 0; ai < 2; ++ai)
#pragma unroll
                for (int m = 0; m < 4; ++m) { const size_t off = (size_t)(rowt + ai * HALF + wr * 64 + m * 16 + fr) * DM + col0;
#pragma unroll
                    for (int bj = 0; bj < 2; ++bj) { const f32x4 b0 = *(const f32x4*)(base32 + off + bj * HALF), b1 = *(const f32x4*)(base32 + off + bj * HALF + 4);
                        *(u32x4*)(out + off + bj * HALF) = pack8(b0 + gv[bj][0] * acc[ai][bj][m][0], b1 + gv[bj][1] * acc[ai][bj][m][1]); }
                    asm volatile("" ::: "memory"); }
        } else {
#pragma unroll
            for (int ai = 0; ai < 2; ++ai)
#pragma unroll
                for (int m = 0; m < 4; ++m) { const size_t off = (size_t)(rowt + ai * HALF + wr * 64 + m * 16 + fr) * DM + col0;
#pragma unroll
                    for (int bj = 0; bj < 2; ++bj) { const u32x4 w = *(const u32x4*)(base16 + off + bj * HALF);
                        const f32x4 b0 = {bf_lo(w.x), bf_hi(w.x), bf_lo(w.y), bf_hi(w.y)}, b1 = {bf_lo(w.z), bf_hi(w.z), bf_lo(w.w), bf_hi(w.w)};
                        *(u32x4*)(out + off + bj * HALF) = pack8(b0 + gv[bj][0] * acc[ai][bj][m][0], b1 + gv[bj][1] * acc[ai][bj][m][1]); }
                    asm volatile("" ::: "memory"); }
        }
    }
};
struct EpiBf16 {
    static constexpr bool PERM = true, KEEP_ACC = false, BMAP = false;
    bf16_t* O; int ldo; int zrows;
    __device__ __forceinline__ void operator()(Acc& acc, const Unit& u, int wr, int wc, int fr, int fq) const {
        const int row0 = u.z * zrows + u.pm * BM + wr * 64 + fr, col0 = u.pn * BM + wc * 32 + 8 * fq;
#pragma unroll
        for (int ai = 0; ai < 2; ++ai)
#pragma unroll
            for (int m = 0; m < 4; ++m) { bf16_t* rowp = O + (size_t)(row0 + ai * HALF + m * 16) * ldo + col0;
#pragma unroll
                for (int bj = 0; bj < 2; ++bj) *(u32x4*)(rowp + bj * HALF) = pack8(acc[ai][bj][m][0], acc[ai][bj][m][1]); }
    }
};
struct EpiChanDft {
    static constexpr bool PERM = true, KEEP_ACC = false, BMAP = true;
    bf16_t* Y1;
    __device__ __forceinline__ void operator()(Acc& acc, const Unit& u, int wr, int wc, int fr, int fq) const {
        const int b = u.z & 7, g = u.z >> 3;
#pragma unroll
        for (int ai = 0; ai < 2; ++ai)
#pragma unroll
            for (int m = 0; m < 4; ++m) { const int j = ai * HALF + wr * 64 + m * 16 + fr;
#pragma unroll
                for (int bj = 0; bj < 2; ++bj) { const int s2 = 4 * u.pn + 2 * bj + (wc >> 1), s1 = 32 * (wc & 1) + 8 * fq;
                    *(u32x4*)(Y1 + ((((size_t)(b * DM + g * 256 + j) * 64 + s2) * 2 + u.pm) * 64 + s1)) = pack8(acc[ai][bj][m][0], acc[ai][bj][m][1]); } }
    }
};
struct EpiFftA {
    static constexpr bool PERM = true, KEEP_ACC = false, BMAP = false;
    bf16_t* Y2;
    __device__ __forceinline__ void operator()(Acc& acc, const Unit& u, int wr, int wc, int fr, int fq) const {
        const int b = u.pn >> 8;
#pragma unroll
        for (int mm = 0; mm < 2; ++mm) { const int k1 = 32 * wr + 16 * mm + fr;
#pragma unroll
            for (int bj = 0; bj < 2; ++bj) { const int c = ((u.pn * 4) & 1023) + 2 * bj + (wc >> 1), s20 = 32 * (wc & 1) + 8 * fq; f32x4 yr[2], yi[2];
#pragma unroll
                for (int n = 0; n < 2; ++n)
#pragma unroll
                    for (int e = 0; e < 4; ++e) { const float th = (float)(k1 * (s20 + 4 * n + e)) * (1.0f / 4096.0f); const float cs = __builtin_amdgcn_cosf(th), sn = __builtin_amdgcn_sinf(th);
                        const float re = acc[0][bj][2 * mm][n][e], im = acc[0][bj][2 * mm + 1][n][e]; yr[n][e] = re * cs + im * sn; yi[n][e] = im * cs - re * sn; }
                bf16_t* dst = Y2 + ((((size_t)(b * 64 + k1) * DM + c) * 2) * 64 + s20);
                *(u32x4*)(dst) = pack8(yr[0], yr[1]); *(u32x4*)(dst + 64) = pack8(yi[0], yi[1]); } }
    }
};
struct EpiFftB {
    static constexpr bool PERM = true, KEEP_ACC = false, BMAP = false;
    bf16_t* FO;
    __device__ __forceinline__ void operator()(Acc& acc, const Unit& u, int wr, int wc, int fr, int fq) const {
        if (wr != 0) return;
        const int bk = u.pn >> 2, b = bk >> 6, k1 = bk & 63, c0 = (u.pn & 3) * 256 + wc * 32 + 8 * fq;
#pragma unroll
        for (int m = 0; m < 4; ++m) { const int k2 = 16 * m + fr; bf16_t* rowp = FO + (size_t)(b * SEQ + k1 + 64 * k2) * DM + c0;
#pragma unroll
            for (int bj = 0; bj < 2; ++bj) *(u32x4*)(rowp + bj * HALF) = pack8(acc[0][bj][m][0], acc[0][bj][m][1]); }
    }
};
struct EpiSwiglu {
    static constexpr bool PERM = true, KEEP_ACC = false, BMAP = false;
    bf16_t* O;
    __device__ __forceinline__ void operator()(Acc& acc, const Unit& u, int wr, int wc, int fr, int fq) const {
        const int row0 = u.pm * BM + wr * 64 + fr, col0 = u.pn * HALF + wc * 32 + 8 * fq;
#pragma unroll
        for (int ai = 0; ai < 2; ++ai)
#pragma unroll
            for (int m = 0; m < 4; ++m) { f32x4 v0, v1;
#pragma unroll
                for (int e = 0; e < 4; ++e) { v0[e] = siluf(acc[ai][0][m][0][e]) * acc[ai][1][m][0][e]; v1[e] = siluf(acc[ai][0][m][1][e]) * acc[ai][1][m][1][e]; }
                *(u32x4*)(O + (size_t)(row0 + ai * HALF + m * 16) * DFF + col0) = pack8(v0, v1); }
    }
};
struct EpiQK {
    static constexpr bool PERM = true, KEEP_ACC = false, BMAP = false;
    bf16_t* A2; bf16_t* KTM; const float* rope  ;
    __device__ __forceinline__ void operator()(Acc& acc, const Unit& u, int wr, int wc, int fr, int fq) const {
        const bool isq = u.pn < 4; const int h = isq ? u.pn : u.pn - 4; const int i0 = wc * 32 + 8 * fq;
        const float lgf = lg2gamma(h), lgb = lg2gamma(3 - h);
#pragma unroll
        for (int ai = 0; ai < 2; ++ai)
#pragma unroll
            for (int m = 0; m < 4; ++m) {
                const int tl = u.pm * BM + ai * HALF + wr * 64 + m * 16 + fr, s = tl % SEQ, sl = s % 512;
                const f32x4* rp = (const f32x4*)(rope + ((size_t)s * 128 + i0) * 2);
                f32x4 o1[2], o2[2];
#pragma unroll
                for (int n = 0; n < 2; ++n) { const f32x4 r0 = rp[2 * n], r1 = rp[2 * n + 1]; const f32x4 x1 = acc[ai][0][m][n], x2 = acc[ai][1][m][n];
                    const float cs[4] = {r0[0], r0[2], r1[0], r1[2]}, sn[4] = {r0[1], r0[3], r1[1], r1[3]};
#pragma unroll
                    for (int e = 0; e < 4; ++e) { o1[n][e] = x1[e] * cs[e] - x2[e] * sn[e]; o2[n][e] = x1[e] * sn[e] + x2[e] * cs[e]; } }
                if (isq) {
                    const float df = exp2f((float)(sl + 1) * lgf), db = exp2f((float)(512 - sl) * lgb);
                    bf16_t* rowp = A2 + ((size_t)tl * 4 + h) * 1024 + 512 + i0;
                    *(u32x4*)(rowp) = pack8(o1[0] * df, o1[1] * df); *(u32x4*)(rowp + 128) = pack8(o2[0] * df, o2[1] * df);
                    *(u32x4*)(rowp + 256) = pack8(o1[0] * db, o1[1] * db); *(u32x4*)(rowp + 384) = pack8(o2[0] * db, o2[1] * db);
                } else {
                    bf16_t* rowp = KTM + (size_t)tl * 1024 + h * 256 + i0;
                    *(u32x4*)(rowp) = pack8(o1[0] * 0.0625f, o1[1] * 0.0625f); *(u32x4*)(rowp + 128) = pack8(o2[0] * 0.0625f, o2[1] * 0.0625f);
                }
            }
    }
};
struct EpiKVT {
    static constexpr bool PERM = true, KEEP_ACC = false, BMAP = false;
    bf16_t* KFT; bf16_t* KBT; bf16_t* B2; const float* ropet  ;
    __device__ __forceinline__ void operator()(Acc& acc, const Unit& u, int wr, int wc, int fr, int fq) const {
        if (u.pm < 4) {
            const int h = u.pm; const float lgf = lg2gamma(h), lgb = lg2gamma(3 - h);
#pragma unroll
            for (int bj = 0; bj < 2; ++bj) {
                const int tl0 = u.pn * BM + bj * HALF + wc * 32 + 8 * fq, b = tl0 / SEQ, s0 = tl0 % SEQ, sl0 = s0 % 512;
                f32x4 kfd[2], kbd[2];
#pragma unroll
                for (int n = 0; n < 2; ++n)
#pragma unroll
                    for (int e = 0; e < 4; ++e) { const int sl = sl0 + 4 * n + e; kfd[n][e] = 0.0625f * exp2f((float)(511 - sl) * lgf); kbd[n][e] = 0.0625f * exp2f((float)sl * lgb); }
#pragma unroll
                for (int m = 0; m < 4; ++m) {
                    const int i = wr * 64 + m * 16 + fr;
                    const f32x4* rp = (const f32x4*)(ropet + ((size_t)i * SEQ + s0) * 2);
                    f32x4 o1[2], o2[2];
#pragma unroll
                    for (int n = 0; n < 2; ++n) { const f32x4 r0 = rp[2 * n], r1 = rp[2 * n + 1]; const f32x4 x1 = acc[0][bj][m][n], x2 = acc[1][bj][m][n];
                        const float cs[4] = {r0[0], r0[2], r1[0], r1[2]}, sn[4] = {r0[1], r0[3], r1[1], r1[3]};
#pragma unroll
                        for (int e = 0; e < 4; ++e) { o1[n][e] = x1[e] * cs[e] - x2[e] * sn[e]; o2[n][e] = x1[e] * sn[e] + x2[e] * cs[e]; } }
                    const size_t r1off = ((size_t)(b * 4 + h) * 256 + i) * SEQ + s0, r2off = r1off + (size_t)128 * SEQ;
                    *(u32x4*)(KFT + r1off) = pack8(o1[0] * kfd[0], o1[1] * kfd[1]); *(u32x4*)(KFT + r2off) = pack8(o2[0] * kfd[0], o2[1] * kfd[1]);
                    *(u32x4*)(KBT + r1off) = pack8(o1[0] * kbd[0], o1[1] * kbd[1]); *(u32x4*)(KBT + r2off) = pack8(o2[0] * kbd[0], o2[1] * kbd[1]);
                }
            }
        } else {
            const int h = (u.pm - 4) >> 1, dv0 = ((u.pm - 4) & 1) * 256;
#pragma unroll
            for (int bj = 0; bj < 2; ++bj) {
                const int tl0 = u.pn * BM + bj * HALF + wc * 32 + 8 * fq, b = tl0 / SEQ, s0 = tl0 % SEQ, np = s0 / 512, sl0 = s0 % 512;
#pragma unroll
                for (int ai = 0; ai < 2; ++ai)
#pragma unroll
                    for (int m = 0; m < 4; ++m) { const int dv = dv0 + ai * HALF + wr * 64 + m * 16 + fr;
                        *(u32x4*)(B2 + (((size_t)((b * 4 + h) * 8 + np) * 512 + dv) * 1024 + sl0)) = pack8(acc[ai][bj][m][0], acc[ai][bj][m][1]); }
            }
        }
    }
};
struct EpiScores {
    static constexpr bool PERM = true, KEEP_ACC = false, BMAP = false;
    bf16_t* A2;
    __device__ __forceinline__ void operator()(Acc& acc, const Unit& u, int wr, int wc, int fr, int fq) const {
        const int np = u.z % 8, h = (u.z / 8) % 4, b = u.z / 32; const float lgf = lg2gamma(h), lgb = lg2gamma(3 - h);
#pragma unroll
        for (int ai = 0; ai < 2; ++ai)
#pragma unroll
            for (int m = 0; m < 4; ++m) { const int t = u.pm * BM + ai * HALF + wr * 64 + m * 16 + fr; const float tf = -(float)(t + 1) * lgf;
                bf16_t* rowp = A2 + ((size_t)(b * SEQ + np * 512 + t) * 4 + h) * 1024;
#pragma unroll
                for (int bj = 0; bj < 2; ++bj) { const int s0 = u.pn * BM + bj * HALF + wc * 32 + 8 * fq; f32x4 v[2];
#pragma unroll
                    for (int n = 0; n < 2; ++n)
#pragma unroll
                        for (int e = 0; e < 4; ++e) { const int s = s0 + 4 * n + e; const float ex = (s <= t) ? -(float)(s + 1) * lgf : (float)(s - t) * lgb + tf; v[n][e] = acc[ai][bj][m][n][e] * exp2f(ex); }
                    *(u32x4*)(rowp + s0) = pack8(v[0], v[1]); } }
    }
};
struct EpiState {
    static constexpr bool PERM = true, KEEP_ACC = false, BMAP = false;
    bf16_t* B2;
    __device__ __forceinline__ void operator()(Acc& acc, const Unit& u, int wr, int wc, int fr, int fq) const {
        const int dvh = u.z & 1, slot = (u.z >> 1) & 7, dir = (u.z >> 4) & 1, bh = u.z >> 5;
        const int col0 = 512 + dir * 256 + wc * 32 + 8 * fq;
#pragma unroll
        for (int ai = 0; ai < 2; ++ai)
#pragma unroll
            for (int m = 0; m < 4; ++m) { const int dv = dvh * 256 + ai * HALF + wr * 64 + m * 16 + fr;
                bf16_t* rowp = B2 + ((size_t)(bh * 8 + slot) * 512 + dv) * 1024 + col0;
#pragma unroll
                for (int bj = 0; bj < 2; ++bj) *(u32x4*)(rowp + bj * HALF) = pack8(acc[ai][bj][m][0], acc[ai][bj][m][1]); }
    }
};
struct StateSched {
    const char* B2; const char* KFT; int G, c;
    __device__ __forceinline__ const char* baseA() const { return B2; }
    __device__ __forceinline__ const char* baseB() const { return KFT; }
    __device__ __forceinline__ bool next(int i, Unit& u) const {
        const int L = i * G + c; if (L >= 448) return false;
        const int dvh = L & 1, t = L >> 1, cidx = t % 7, t2 = t / 7, dir = t2 & 1, bh = t2 >> 1;
        const int ci = dir ? 7 - cidx : cidx, slot = dir ? ci - 1 : ci + 1;
        u.pm = 0; u.pn = 0; u.z = ((bh * 2 + dir) * 8 + slot) * 2 + dvh;
        u.ao = (unsigned)(((bh * 8 + ci) * 512 + dvh * 256) * 8);
        u.bo = (unsigned)(dir * 131072 + bh * 256 * 32 + ci * 4);
        return true;
    }
};
struct EpiRetOut {
    static constexpr bool PERM = true, KEEP_ACC = false, BMAP = false;
    bf16_t* Y; float* stats;
    __device__ __forceinline__ void operator()(Acc& acc, const Unit& u, int wr, int wc, int fr, int fq) const {
        const int np = u.z % 8, h = (u.z / 8) % 4, b = u.z / 32;
#pragma unroll
        for (int ai = 0; ai < 2; ++ai)
#pragma unroll
            for (int m = 0; m < 4; ++m) { const int tl = b * SEQ + np * 512 + u.pm * BM + ai * HALF + wr * 64 + m * 16 + fr;
                float s = 0.f, q = 0.f;
#pragma unroll
                for (int bj = 0; bj < 2; ++bj)
#pragma unroll
                    for (int n = 0; n < 2; ++n) { const f32x4 x = acc[ai][bj][m][n]; s += (x[0] + x[1]) + (x[2] + x[3]); q += (x[0] * x[0] + x[1] * x[1]) + (x[2] * x[2] + x[3] * x[3]); }
                s += __shfl_xor(s, 16); s += __shfl_xor(s, 32); q += __shfl_xor(q, 16); q += __shfl_xor(q, 32);
                if (fq == 0) *(f32x2*)(stats + (((size_t)tl * 4 + h) * 8 + u.pn * 4 + wc) * 2) = (f32x2){s, q};
                bf16_t* rowp = Y + (size_t)tl * 2048 + h * 512 + u.pn * BM + wc * 32 + 8 * fq;
#pragma unroll
                for (int bj = 0; bj < 2; ++bj) *(u32x4*)(rowp + bj * HALF) = pack8(acc[ai][bj][m][0], acc[ai][bj][m][1]); }
    }
};
struct EpiGate {
    static constexpr bool PERM = true, KEEP_ACC = false, BMAP = false;
    bf16_t* Y; const float* stats;
    __device__ __forceinline__ void operator()(Acc& acc, const Unit& u, int wr, int wc, int fr, int fq) const {
        const int h = u.pn >> 1;
#pragma unroll
        for (int ai = 0; ai < 2; ++ai)
#pragma unroll
            for (int m = 0; m < 4; ++m) { const int tl = u.pm * BM + ai * HALF + wr * 64 + m * 16 + fr;
                const f32x4* sp = (const f32x4*)(stats + ((size_t)tl * 4 + h) * 16); float s = 0.f, q = 0.f;
#pragma unroll
                for (int k = 0; k < 4; ++k) { const f32x4 v = sp[k]; s += v[0] + v[2]; q += v[1] + v[3]; }
                const float mu = s * (1.0f / 512.0f), var = fmaxf(q * (1.0f / 512.0f) - mu * mu, 0.f), rstd = rsqrtf(var + 1e-6f);
                bf16_t* rowp = Y + (size_t)tl * 2048 + u.pn * BM + wc * 32 + 8 * fq;
#pragma unroll
                for (int bj = 0; bj < 2; ++bj) { const u32x4 yw = *(const u32x4*)(rowp + bj * HALF);
                    const float yv[8] = {bf_lo(yw.x), bf_hi(yw.x), bf_lo(yw.y), bf_hi(yw.y), bf_lo(yw.z), bf_hi(yw.z), bf_lo(yw.w), bf_hi(yw.w)};
                    f32x4 v0, v1;
#pragma unroll
                    for (int e = 0; e < 4; ++e) { v0[e] = siluf(acc[ai][bj][m][0][e]) * (yv[e] - mu) * rstd; v1[e] = siluf(acc[ai][bj][m][1][e]) * (yv[4 + e] - mu) * rstd; }
                    *(u32x4*)(rowp + bj * HALF) = pack8(v0, v1); }
                asm volatile("" ::: "memory"); }
    }
};

template <int MODE>
__device__ __forceinline__ void conv_weight(const int tid, const float* W, int K, int N, bf16_t* WT, int bx, int G) {
    const int nitems = (K >> 3) * N;
#pragma unroll 2
    for (int idx = bx * 512 + tid; idx < nitems; idx += G * 512) {
        const int n = idx % N, k0 = (idx / N) * 8; float v[8];
#pragma unroll
        for (int e = 0; e < 8; ++e) v[e] = W[(size_t)(k0 + e) * N + n];
        int nn = n;
        if (MODE == 1) { const int j = nn < DFF ? nn : nn - DFF; nn = 256 * (j >> 7) + (nn < DFF ? 0 : 128) + (j & 127); }
        u32x4 w; w.x = cvt_pk_bf16(v[0], v[1]); w.y = cvt_pk_bf16(v[2], v[3]); w.z = cvt_pk_bf16(v[4], v[5]); w.w = cvt_pk_bf16(v[6], v[7]);
        *(u32x4*)(WT + (size_t)nn * K + k0) = w;
    }
}
template <bool IN16, bool FINAL>
__device__ __forceinline__ void norm_rows(const int tid, const int bx, const int G, const float* x32, const bf16_t* x16, const float* g, const float* mod, int shoff, int scoff, bf16_t* h, float* outf) {
    const int lane = tid & 63, gw = bx * 8 + (tid >> 6), nw = G * 8;
#pragma unroll 2
    for (int r = gw; r < NTOK; r += nw) {
        const int b = r / SEQ; f32x4 v[2][2]; float ss = 0.f;
#pragma unroll
        for (int j = 0; j < 2; ++j) { const size_t off = (size_t)r * DM + j * 512 + lane * 8;
            if (IN16) { const u32x4 w = *(const u32x4*)(x16 + off); v[j][0] = (f32x4){bf_lo(w.x), bf_hi(w.x), bf_lo(w.y), bf_hi(w.y)}; v[j][1] = (f32x4){bf_lo(w.z), bf_hi(w.z), bf_lo(w.w), bf_hi(w.w)}; }
            else { v[j][0] = *(const f32x4*)(x32 + off); v[j][1] = *(const f32x4*)(x32 + off + 4); }
#pragma unroll
            for (int q = 0; q < 2; ++q) ss += (v[j][q][0] * v[j][q][0] + v[j][q][1] * v[j][q][1]) + (v[j][q][2] * v[j][q][2] + v[j][q][3] * v[j][q][3]); }
#pragma unroll
        for (int o = 32; o >= 1; o >>= 1) ss += __shfl_xor(ss, o);
        const float rs = rsqrtf(ss * (1.0f / 1024.0f) + 1e-6f);
#pragma unroll
        for (int j = 0; j < 2; ++j) { const int col = j * 512 + lane * 8; f32x4 y[2];
#pragma unroll
            for (int q = 0; q < 2; ++q) { const f32x4 gg = *(const f32x4*)(g + col + 4 * q), sc = *(const f32x4*)(mod + (size_t)b * MODW + scoff + col + 4 * q), sh = *(const f32x4*)(mod + (size_t)b * MODW + shoff + col + 4 * q);
                y[q] = (v[j][q] * rs) * gg * (sc + 1.0f) + sh; }
            if (FINAL) { *(f32x4*)(outf + (size_t)r * DM + col) = y[0]; *(f32x4*)(outf + (size_t)r * DM + col + 4) = y[1]; }
            else *(u32x4*)(h + (size_t)r * DM + col) = pack8(y[0], y[1]); }
    }
}

#define XB_TMO      128
#define XB_XCNT(j)  (256  + 64 * (j))
#define XB_XSUB(j)  (1280 + 64 * (j))
#define XB_XGEN(j)  (2304 + 64 * (j))
#define XB_TOP      3328
#define XB_TOPGEN   3392
#define XCD_BAR_WORDS 3456
#define XB_SPIN_CAP (1u << 18)
__device__ __forceinline__ unsigned xb_ld(unsigned* p)              { return __hip_atomic_load(p, __ATOMIC_RELAXED, __HIP_MEMORY_SCOPE_AGENT); }
__device__ __forceinline__ unsigned xb_add(unsigned* p, unsigned v) { return __hip_atomic_fetch_add(p, v, __ATOMIC_RELAXED, __HIP_MEMORY_SCOPE_AGENT); }
__device__ __forceinline__ unsigned xb_xcc_id() { return (unsigned)__builtin_amdgcn_s_getreg((3 << 11) | 20) & 0xFu; }
#define XB_SPIN(cond, bar) do { unsigned _sp = 0; while (cond) { __builtin_amdgcn_s_sleep(1); \
    if ((++_sp & 255u) == 0u) { if (xb_ld(&(bar)[XB_TMO])) break; if (_sp > XB_SPIN_CAP) { atomicAdd(&(bar)[XB_TMO], 1u); break; } } } } while (0)
__device__ __forceinline__ void xcd_barrier_complete(unsigned* bar, unsigned x, unsigned& nloc, unsigned& nx) {
    const unsigned G = gridDim.x * gridDim.y * gridDim.z;
    unsigned sum, cnt, mine, sp = 0u;
    for (;;) {
        sum = 0u; cnt = 0u; mine = 0u;
#pragma unroll
        for (unsigned j = 0; j < 16; ++j) { const unsigned c = xb_ld(&bar[XB_XCNT(j)]); sum += c; cnt += (c > 0u) ? 1u : 0u; mine = (j == x) ? c : mine; }
        if (sum == G) break;
        __builtin_amdgcn_s_sleep(1);
        if ((++sp & 255u) == 0u) { if (xb_ld(&bar[XB_TMO])) break; if (sp > XB_SPIN_CAP) { atomicAdd(&bar[XB_TMO], 1u); break; } }
    }
    nloc = mine > 0u ? mine : 1u; nx = cnt > 0u ? cnt : 1u;
}
__device__ __forceinline__ void xcd_barrier(unsigned* bar, volatile LAS unsigned* st, const int tid) {
    asm volatile("s_waitcnt vmcnt(0)" ::: "memory");
    __syncthreads();
    if (tid == 0) {
        const unsigned x = xb_xcc_id();
        __builtin_amdgcn_s_waitcnt(0);
        unsigned nloc = st[0], nx = st[1];
        if (nloc == 0u) { xcd_barrier_complete(bar, x, nloc, nx); st[0] = nloc; st[1] = nx; }
        const unsigned old = xb_add(&bar[XB_XSUB(x)], 1u);
        const unsigned gen = old / nloc;
        if (old + 1u == (gen + 1u) * nloc) {
            __builtin_amdgcn_fence(__ATOMIC_RELEASE, "agent");
            asm volatile("s_waitcnt vmcnt(0)" ::: "memory");
            const unsigned og = xb_add(&bar[XB_TOP], 1u);
            const unsigned tg = og / nx;
            if (og + 1u == (tg + 1u) * nx) xb_add(&bar[XB_TOPGEN], 1u);
            else XB_SPIN(xb_ld(&bar[XB_TOPGEN]) == tg, bar);
            __builtin_amdgcn_fence(__ATOMIC_ACQUIRE, "agent");
            xb_add(&bar[XB_XGEN(x)], 1u);
            asm volatile("s_waitcnt vmcnt(0)" ::: "memory");
        } else {
            XB_SPIN(xb_ld(&bar[XB_XGEN(x)]) == gen, bar);
            __builtin_amdgcn_fence(__ATOMIC_ACQUIRE, "agent");
            asm volatile("s_waitcnt vmcnt(0)" ::: "memory");
        }
    }
    __syncthreads();
}

struct Params { const float* in[14]; float* out; unsigned char* ws; int ph_lo, ph_hi; };

enum { K_GEMV = 0, K_MODFIN, K_PREP, K_F1, K_FA, K_FB, K_N2, K_FF1, K_RESID, K_P1, K_P2S, K_PFX, K_P5, K_GATE, K_FINAL };
enum { R_F3 = 0, R_WOUT, R_FF2 };

__device__ __forceinline__ void plain_sched(GSched& S, int nM, int nN, int G, int c, const void* A, const void* B, int lda, int ldb) {
    S.o.init(nM, nN, 1, G, c); S.A = (const char*)A; S.B = (const char*)B; S.n1 = 1; S.n0 = 1;
    S.a2 = 0; S.a1 = 0; S.a0 = 0; S.apm = (unsigned)(2 * lda); S.b2 = 0; S.b1 = 0; S.b0 = 0; S.bpn = (unsigned)(2 * ldb);
}

__global__ void __launch_bounds__(512, 2) mega(Params p) {
    extern __shared__ __attribute__((aligned(16))) unsigned char shm[];
    {   volatile LAS unsigned* st0 = (volatile LAS unsigned*)((LAS unsigned char*)shm + STAGE_BYTES + 768);
        if (threadIdx.x == 0) { st0[0] = 0u; st0[1] = 0u; (void)xb_add(&((unsigned*)(p.ws + WS_BAR))[XB_XCNT(xb_xcc_id())], 1u); }
        __syncthreads(); }
    for (int pph = p.ph_lo; pph < p.ph_hi; ++pph) {
        int ph = pph;
        if (PROBE_NDUP > 0) { const int dups[] = {PROBE_DUPS}; int sub = 0;
#pragma unroll
            for (int i = 0; i < PROBE_NDUP; ++i) sub += (dups[i] + i + 1 <= pph) ? 1 : 0;
            ph = pph - sub; }
        int tid_ = threadIdx.x, G_ = gridDim.x, bx_ = blockIdx.x; unsigned char* ws_ = p.ws; float* xres_ = p.out; unsigned ldsa = 0;
        asm volatile("" : "+v"(tid_), "+s"(G_), "+s"(bx_), "+s"(ldsa));
        const int tid = tid_, lane = tid & 63, wid = tid >> 6, G = G_, bx = bx_; unsigned char* const ws = ws_; float* const xres = xres_;
        LAS unsigned char* const lds = (LAS unsigned char*)shm + ldsa;
        int kind, l = 0, half = 0, rk = 0;
        if (ph < 2) kind = ph;
        else if (ph == 50) kind = K_FINAL;
        else {
            const int q = ph - 2, pair = q / 24, r = q % 24;
            if (r < 8) { l = 2 * pair; kind = r == 0 ? K_PREP : r == 1 ? K_F1 : r == 2 ? K_FA : r == 3 ? K_FB : r == 4 ? K_RESID : r == 5 ? K_N2 : r == 6 ? K_FF1 : K_RESID; rk = r == 4 ? R_F3 : R_FF2; }
            else { l = 2 * pair + 1; const int r2 = r - 8;
                if (r2 == 0) kind = K_PREP;
                else if (r2 <= 12) { half = (r2 - 1) / 6; const int sub = (r2 - 1) % 6; kind = sub == 0 ? K_P1 : sub == 1 ? K_P2S : sub == 2 ? K_PFX : sub == 3 ? K_P5 : sub == 4 ? K_GATE : K_RESID; rk = R_WOUT; }
                else { kind = r2 == 13 ? K_N2 : r2 == 14 ? K_FF1 : K_RESID; rk = R_FF2; } }
        }
        float* MOD = (float*)(ws + WS_MOD);
        const float* modl = MOD + l * 6144;
        bf16_t* const H = (bf16_t*)((unsigned char*)xres + 64 * MiB);
        bf16_t* const X16 = (bf16_t*)(ws + WS_H);
        switch (kind) {
        case K_GEMV: {
            const float* c_in = p.in[1]; const float* w_ada = p.in[2]; const float* w_ada_f = p.in[12];
            float* MODP = (float*)(ws + WS_MODP); float* ROPE = (float*)(ws + WS_ROPE); float* ROPET = (float*)(ws + WS_ROPET); bf16_t* CS = (bf16_t*)(ws + WS_CS);
            LAS float* cact = (LAS float*)lds;
            for (int i = tid; i < 8 * DM; i += 512) { const float v = c_in[i]; cact[i] = v / (1.0f + __expf(-v)); }
            __syncthreads();
            int vz = 0; asm volatile("" : "+v"(vz));
#pragma unroll 1
            for (int w = bx * 8 + wid; w < 104 * 16; w += G * 8) {
                const int cgp = w % 104, ks = w / 104, gc = cgp * 256 + lane * 4;
                const float* Wp; int ldw;
                if (gc < 24576) { const int ll = gc / 6144; Wp = w_ada + (size_t)ll * DM * 6144 + (gc - ll * 6144); ldw = 6144; } else { Wp = w_ada_f + (gc - 24576); ldw = 2048; }
                f32x4 a[8];
#pragma unroll
                for (int b = 0; b < 8; ++b) a[b] = (f32x4){0.f, 0.f, 0.f, 0.f};
#pragma unroll 4
                for (int k = ks * 64; k < ks * 64 + 64; ++k) { const f32x4 wv = *(const f32x4*)(Wp + (size_t)k * ldw);
#pragma unroll
                    for (int b = 0; b < 8; ++b) a[b] += wv * cact[b * DM + k + vz]; }
#pragma unroll
                for (int b = 0; b < 8; ++b) *(f32x4*)(MODP + ((size_t)(ks * 8 + b)) * MODW + gc) = a[b];
            }
#pragma unroll 1
            for (int idx = bx * 512 + tid; idx < SEQ * 128; idx += G * 512) {
                const int s = idx >> 7, i = idx & 127;
                const float invf = exp2f(-(float)i * (13.287712379549449f / 128.0f));
                const float ang = (float)s * invf;
                const double rev = (double)ang * 0.15915494309189535; const float fr_ = (float)(rev - floor(rev));
                const float sn = __builtin_amdgcn_sinf(fr_), cs = __builtin_amdgcn_cosf(fr_);
                *(f32x2*)(ROPE + (size_t)idx * 2) = (f32x2){cs, sn};
                *(f32x2*)(ROPET + ((size_t)i * SEQ + s) * 2) = (f32x2){cs, sn};
            }
#pragma unroll 1
            for (int idx = bx * 512 + tid; idx < 512 * 256; idx += G * 512) {
                const int row = idx >> 8, d = idx & 255, j = row & 255, part = row >> 8; const float fr_ = (float)((j * d) & 255) * (1.0f / 256.0f);
                const float v = (part ? __builtin_amdgcn_sinf(fr_) : __builtin_amdgcn_cosf(fr_)) * 0.0625f;
                CS[idx] = (bf16_t)(cvt_pk_bf16(v, 0.f) & 0xffffu);
            }
            {   bf16_t* TA = (bf16_t*)(ws + WS_TA); bf16_t* TB = (bf16_t*)(ws + WS_TB);
#pragma unroll 1
                for (int idx = bx * 512 + tid; idx < 256 * 128; idx += G * 512) {
                    const int row = idx >> 7, kk = idx & 127, pin = kk >> 6, sx = kk & 63;
                    float va = 0.f, vb = 0.f;
                    if (row < 128) { const int wr_ = row >> 6, m_ = (row >> 4) & 3, fr_ = row & 15, k1 = 32 * wr_ + 16 * (m_ >> 1) + fr_, pout = m_ & 1; const float th = (float)((k1 * sx) & 63) * (1.0f / 64.0f);
                        const float cs = __builtin_amdgcn_cosf(th), sn = __builtin_amdgcn_sinf(th); va = (pout == 0 ? (pin == 0 ? cs : -sn) : (pin == 0 ? -sn : -cs)) * 0.125f; }
                    if (row < 64) { const float th = (float)((row * sx) & 63) * (1.0f / 64.0f); vb = (pin == 0 ? __builtin_amdgcn_cosf(th) : __builtin_amdgcn_sinf(th)) * 0.125f; }
                    TA[idx] = (bf16_t)(cvt_pk_bf16(va, 0.f) & 0xffffu); TB[idx] = (bf16_t)(cvt_pk_bf16(vb, 0.f) & 0xffffu);
                } }
        } break;
        case K_MODFIN: {
            const float* b_ada = p.in[3]; const float* b_ada_f = p.in[13]; const float* MODP = (const float*)(ws + WS_MODP);
#pragma unroll 1
            for (int idx = bx * 512 + tid; idx < 8 * MODW; idx += G * 512) {
                const int b = idx / MODW, gc = idx % MODW; float s = gc < 24576 ? b_ada[gc] : b_ada_f[gc - 24576];
#pragma unroll
                for (int ks = 0; ks < 16; ++ks) s += MODP[((size_t)(ks * 8 + b)) * MODW + gc];
                MOD[idx] = s;
            }
        } break;
        case K_PREP: {
            const bool fourier = (l & 1) == 0; const int j = l >> 1;
            if (fourier) {
                conv_weight<0>(tid, p.in[6] + (size_t)j * DM * DM, DM, DM, (bf16_t*)(ws + W_MIXIN), bx, G);
            } else {
                conv_weight<0>(tid, p.in[7] + (size_t)j * DM * 6144, DM, 6144, (bf16_t*)(ws + W_MIXIN), bx, G);
                conv_weight<0>(tid, p.in[8] + (size_t)j * 2048 * DM, 2048, DM, (bf16_t*)(ws + W_MIXOUT), bx, G);
            }
            conv_weight<1>(tid, p.in[9] + (size_t)l * DM * 2 * DFF, DM, 2 * DFF, (bf16_t*)(ws + W_FFNIN), bx, G);
            conv_weight<0>(tid, p.in[10] + (size_t)l * DFF * DM, DFF, DM, (bf16_t*)(ws + W_FFNOUT), bx, G);
            __syncthreads();
            if (l == 0) norm_rows<false, false>(tid, bx, G, p.in[0], nullptr, p.in[4] + l * DM, modl, 0, 1024, H, nullptr);
            else norm_rows<true, false>(tid, bx, G, nullptr, X16, p.in[4] + l * DM, modl, 0, 1024, H, nullptr);
        } break;
        case K_F1: {
            GSched S; S.o.init(2, 16, 32, G, bx); S.A = (const char*)(ws + WS_CS); S.B = (const char*)H; S.n1 = 4; S.n0 = 8;
            S.a2 = 0; S.a1 = 0; S.a0 = 0; S.apm = 2 * 256; S.b2 = 0; S.b1 = 2; S.b0 = SEQ * 8; S.bpn = 4 * 8;
            EpiChanDft E{(bf16_t*)(ws + WS_Y1)};
            gemm_phase(tid, lds, S, E, 256, DM, 4);
        } break;
        case K_FA: {
            GSched S; plain_sched(S, 1, 2048, G, bx, ws + WS_TA, ws + WS_Y1, 128, 128);
            EpiFftA E{(bf16_t*)(ws + WS_Y2)};
            gemm_phase(tid, lds, S, E, 128, 128, 2);
        } break;
        case K_FB: {
            GSched S; plain_sched(S, 1, 2048, G, bx, ws + WS_TB, ws + WS_Y2, 128, 128);
            EpiFftB E{(bf16_t*)(ws + WS_FO)};
            gemm_phase(tid, lds, S, E, 128, 128, 2);
        } break;
        case K_N2: {
            norm_rows<true, false>(tid, bx, G, nullptr, X16, p.in[5] + l * DM, modl, 3072, 4096, H, nullptr);
        } break;
        case K_FF1: {
            GSched S; plain_sched(S, 128, 22, G, bx, H, ws + W_FFNIN, DM, DM);
            EpiSwiglu E{(bf16_t*)(ws + WS_HID)};
            gemm_phase(tid, lds, S, E, DM, DM, 16);
        } break;
        case K_RESID: {
            GSched S; EpiResid E; int ld, nt;
            if (rk == R_F3) { ld = DM; nt = 16; plain_sched(S, 128, 4, G, bx, ws + WS_FO, ws + W_MIXIN, ld, ld); E = EpiResid{l == 0 ? p.in[0] : nullptr, X16, X16, modl + 2048, 0}; }
            else if (rk == R_WOUT) { ld = 2048; nt = 32; plain_sched(S, 64, 4, G, bx, ws + WS_Y, ws + W_MIXOUT, ld, ld); E = EpiResid{nullptr, X16, X16, modl + 2048, half * HTOK}; }
            else { ld = DFF; nt = 44; plain_sched(S, 128, 4, G, bx, ws + WS_HID, ws + W_FFNOUT, ld, ld); E = EpiResid{nullptr, X16, X16, modl + 5120, 0}; }
            gemm_phase(tid, lds, S, E, ld, ld, nt);
        } break;
        case K_P1: {
            const bf16_t* Hh = H + (size_t)half * HTOK * DM; const bf16_t* WTin = (const bf16_t*)(ws + W_MIXIN);
            { GSched S; plain_sched(S, 64, 8, G, bx, Hh, WTin, DM, DM);
              EpiQK E{(bf16_t*)(ws + WS_A2), (bf16_t*)(ws + WS_KTM), (const float*)(ws + WS_ROPE)};
              gemm_phase(tid, lds, S, E, DM, DM, 16); }
            { GSched S; plain_sched(S, 12, 64, G, bx, WTin + (size_t)1024 * DM, Hh, DM, DM);
              EpiKVT E{(bf16_t*)(ws + WS_KFT), (bf16_t*)(ws + WS_KBT), (bf16_t*)(ws + WS_B2), (const float*)(ws + WS_ROPET)};
              gemm_phase(tid, lds, S, E, DM, DM, 16); }
        } break;
        case K_P2S: {
            bf16_t* A2 = (bf16_t*)(ws + WS_A2); bf16_t* B2 = (bf16_t*)(ws + WS_B2);
            { StateSched S{(const char*)B2, (const char*)(ws + WS_KFT), G, bx};
              EpiState E{B2};
              gemm_phase(tid, lds, S, E, 1024, SEQ, 8); }
            { GSched S; S.o.init(2, 2, 128, G, G - 1 - bx); S.A = (const char*)(A2 + 512); S.B = (const char*)(ws + WS_KTM); S.n1 = 4; S.n0 = 8;
              S.a2 = SEQ * 32; S.a1 = 8; S.a0 = 512 * 32; S.apm = 256 * 32;
              S.b2 = SEQ * 8; S.b1 = 2; S.b0 = 512 * 8; S.bpn = 256 * 8;
              EpiScores E{A2};
              gemm_phase(tid, lds, S, E, 4096, DM, 4); }
        } break;
        case K_PFX: {
            bf16_t* B2 = (bf16_t*)(ws + WS_B2);
#pragma unroll 1
            for (int it = bx * 512 + tid; it < 16 * 512 * 64; it += G * 512) {
                const int c8 = it & 63, dv = (it >> 6) & 511, bh = it >> 15, dir = c8 >> 5, h = bh & 3;
                const float dec = exp2f(512.0f * lg2gamma(dir ? 3 - h : h));
                bf16_t* p0 = B2 + ((size_t)(bh * 8) * 512 + dv) * 1024 + 512 + c8 * 8;
                float R[8];
#pragma unroll
                for (int e = 0; e < 8; ++e) R[e] = 0.f;
                u32x4 sv[7];
#pragma unroll
                for (int k = 0; k < 7; ++k) { const int slot = dir ? 6 - k : k + 1; sv[k] = *(const u32x4*)(p0 + (size_t)slot * 512 * 1024); }
                { unsigned zz = 0; asm volatile("" : "+v"(zz)); *(u32x4*)(p0 + (size_t)(dir ? 7 : 0) * 512 * 1024) = (u32x4){zz, zz, zz, zz}; }
#pragma unroll
                for (int k = 0; k < 7; ++k) { const int slot = dir ? 6 - k : k + 1; const u32x4 w = sv[k];
                    const float s[8] = {bf_lo(w.x), bf_hi(w.x), bf_lo(w.y), bf_hi(w.y), bf_lo(w.z), bf_hi(w.z), bf_lo(w.w), bf_hi(w.w)};
#pragma unroll
                    for (int e = 0; e < 8; ++e) R[e] = R[e] * dec + s[e];
                    u32x4 o; o.x = cvt_pk_bf16(R[0], R[1]); o.y = cvt_pk_bf16(R[2], R[3]); o.z = cvt_pk_bf16(R[4], R[5]); o.w = cvt_pk_bf16(R[6], R[7]);
                    *(u32x4*)(p0 + (size_t)slot * 512 * 1024) = o; }
            }
        } break;
        case K_P5: {
            GSched S; S.o.init(2, 2, 128, G, bx); S.A = (const char*)(ws + WS_A2); S.B = (const char*)(ws + WS_B2); S.n1 = 4; S.n0 = 8;
            S.a2 = SEQ * 32; S.a1 = 8; S.a0 = 512 * 32; S.apm = 256 * 32;
            S.b2 = 32 * 512 * 8; S.b1 = 8 * 512 * 8; S.b0 = 512 * 8; S.bpn = 256 * 8;
            EpiRetOut E{(bf16_t*)(ws + WS_Y), (float*)(ws + WS_STATS)};
            gemm_phase(tid, lds, S, E, 4096, 1024, 16);
        } break;
        case K_GATE: {
            GSched S; plain_sched(S, 64, 8, G, bx, H + (size_t)half * HTOK * DM, (const bf16_t*)(ws + W_MIXIN) + (size_t)4096 * DM, DM, DM);
            EpiGate E{(bf16_t*)(ws + WS_Y), (const float*)(ws + WS_STATS)};
            gemm_phase(tid, lds, S, E, DM, DM, 16);
        } break;
        default: {
            norm_rows<true, true>(tid, bx, G, nullptr, X16, p.in[11], MOD + 24576, 0, 1024, nullptr, xres);
        } break;
        }
        if (pph + 1 < p.ph_hi) {
            if (pph == p.ph_lo) cg::this_grid().sync();
            else xcd_barrier((unsigned*)(ws + WS_BAR), (volatile LAS unsigned*)(lds + STAGE_BYTES + 768), tid);
        }
    }
}
constexpr int N_PHASES = 2 + 2 * (1 + 4 + 3) + 2 * (1 + 12 + 3) + 1 + PROBE_NDUP;

extern "C" void kernel_launch(void* const* d_in, const int* in_sizes, int n_in, void* d_out, int out_size, void* d_ws, size_t ws_size, hipStream_t stream) {
    static int grid = 0;
    if (grid == 0) {
        if (n_in != 14 || ws_size < WS_END) { fprintf(stderr, "kernel_launch: unexpected n_in %d or ws_size %zu (< %zu)\n", n_in, ws_size, (size_t)WS_END); grid = -1; return; }
        int dev = 0, cus = 0, per_cu = 0;
        hipGetDevice(&dev); hipDeviceGetAttribute(&cus, hipDeviceAttributeMultiprocessorCount, dev);
        if (hipFuncSetAttribute((const void*)mega, hipFuncAttributeMaxDynamicSharedMemorySize, LDS_BYTES) != hipSuccess) { fprintf(stderr, "kernel_launch: hipFuncSetAttribute failed\n"); grid = -1; return; }
        hipOccupancyMaxActiveBlocksPerMultiprocessor(&per_cu, (const void*)mega, 512, LDS_BYTES);
        (void)hipGetLastError();
        if (per_cu < 1) { fprintf(stderr, "kernel_launch: occupancy query says %d blocks per CU\n", per_cu); per_cu = 1; }
        grid = cus;
    }
    if (grid < 0) return;
    Params p{};
    for (int i = 0; i < 14; ++i) p.in[i] = (const float*)d_in[i];
    p.out = (float*)d_out; p.ws = (unsigned char*)d_ws;
#if MULTI_LAUNCH
    for (int k = 0; k < N_PHASES; ++k) { p.ph_lo = k; p.ph_hi = k + 1; hipLaunchKernelGGL(mega, dim3(grid), dim3(512), LDS_BYTES, stream, p); }
#else
    p.ph_lo = 0; p.ph_hi = N_PHASES;
    if (hipMemsetAsync((char*)d_ws + WS_BAR, 0, XCD_BAR_WORDS * 4, stream) != hipSuccess) { fprintf(stderr, "kernel_launch: memset of the barrier words failed\n"); return; }
    void* args[] = {&p};
    hipError_t e = hipLaunchCooperativeKernel((const void*)mega, dim3(grid), dim3(512), args, LDS_BYTES, stream);
    if (e != hipSuccess) fprintf(stderr, "cooperative launch failed: %s (grid %d)\n", hipGetErrorString(e), grid);
#endif
}
```

```cpp
#include <hip/hip_runtime.h>
#include <hip/hip_cooperative_groups.h>
#include <cstdio>
namespace cg = cooperative_groups;

#ifndef MULTI_LAUNCH
#define MULTI_LAUNCH 0
#endif
#ifndef PROBE_NDUP
#define PROBE_NDUP 0
#define PROBE_DUPS 0
#endif

#define LAS __attribute__((address_space(3)))
typedef unsigned short bf16_t;
typedef short bf16x8 __attribute__((ext_vector_type(8)));
typedef float f32x4 __attribute__((ext_vector_type(4)));
typedef float f32x2 __attribute__((ext_vector_type(2)));
typedef unsigned u32x4 __attribute__((ext_vector_type(4)));
typedef unsigned u32x2 __attribute__((ext_vector_type(2)));

constexpr int NTOK = 32768, SEQ = 4096, DM = 1024, DFF = 2816, HTOK = 16384;
constexpr int BM = 256, BK = 64, HALF = 128, HTB = HALF * BK * 2, STAGE_BYTES = 8 * HTB, NXCD = 8, WGM = 8;
constexpr int MODW = 26624;
constexpr int LDS_BYTES = STAGE_BYTES + 1024;
constexpr size_t MiB = 1048576;
constexpr size_t WS_MOD = 0, WS_ROPE = 1 * MiB, WS_ROPET = 5 * MiB, WS_CS = 9 * MiB, WS_STATS = 10 * MiB;
constexpr size_t WS_BAR = 900 * 1024;
constexpr size_t WS_W = 14 * MiB;
constexpr size_t W_MIXIN = WS_W, W_MIXOUT = WS_W + 12 * MiB, W_FFNIN = WS_W + 16 * MiB, W_FFNOUT = WS_W + 27 * MiB;
constexpr size_t WS_H = 47 * MiB;
constexpr size_t WS_BIG = 111 * MiB;
constexpr size_t WS_Y1 = WS_BIG, WS_Y2 = WS_BIG + 128 * MiB, WS_FO = WS_BIG + 256 * MiB;
constexpr size_t WS_TA = WS_CS + 256 * 1024, WS_TB = WS_TA + 64 * 1024;
constexpr size_t WS_A2 = WS_BIG, WS_B2 = WS_BIG + 128 * MiB, WS_KTM = WS_BIG + 256 * MiB, WS_KFT = WS_BIG + 288 * MiB, WS_KBT = WS_BIG + 320 * MiB;
constexpr size_t WS_Y = WS_KTM;
constexpr size_t WS_HID = WS_BIG, WS_MODP = WS_BIG;
constexpr size_t WS_END = WS_BIG + 352 * MiB;

__device__ __forceinline__ int lds_byte(int r, int c) { const int st = (r >> 4) * 2 + (c >> 5), rr = r & 15, cc = c & 31, ob = rr * 64 + cc * 2; return st * 1024 + (ob ^ (((ob >> 9) & 1) << 5)); }
__device__ __forceinline__ void stage_rc(int b, int& R, int& C) { const int st = b / 1024, sb = b % 1024, swz = sb ^ (((sb >> 9) & 1) << 5); R = (st >> 1) * 16 + swz / 64; C = (st & 1) * 32 + (swz % 64) / 2; }
__device__ __forceinline__ int perm32(int rho) { const int n = rho >> 4, i = rho & 15; return 8 * (i >> 2) + 4 * n + (i & 3); }
__device__ __forceinline__ unsigned cvt_pk_bf16(float lo, float hi) { unsigned r; asm volatile("v_cvt_pk_bf16_f32 %0, %1, %2" : "=v"(r) : "v"(lo), "v"(hi)); return r; }
__device__ __forceinline__ u32x4 pack8(const f32x4 a, const f32x4 b) { u32x4 w; w.x = cvt_pk_bf16(a[0], a[1]); w.y = cvt_pk_bf16(a[2], a[3]); w.z = cvt_pk_bf16(b[0], b[1]); w.w = cvt_pk_bf16(b[2], b[3]); return w; }
__device__ __forceinline__ float bf_lo(unsigned w) { return __uint_as_float(w << 16); }
__device__ __forceinline__ float bf_hi(unsigned w) { return __uint_as_float(w & 0xffff0000u); }
__device__ __forceinline__ float siluf(float v) { return v * __builtin_amdgcn_rcpf(1.0f + __expf(-v)); }
__device__ __forceinline__ float lg2gamma(int h) { return log2f(1.0f - exp2f(-5.0f - (float)h)); }

struct Unit { unsigned ao, bo; int pm, pn, z; };

struct Order {
    int nM, nN, total, G, c;
    __device__ __forceinline__ void init(int nM_, int nN_, int nz, int G_, int c_) { nM = nM_; nN = nN_; total = nM_ * nN_ * nz; G = G_; c = c_; }
    __device__ __forceinline__ bool get(int i, int& z, int& pm, int& pn) const {
        const int L = i * G + c; if (L >= total) return false;
        int wgid = L; { const int q = total / NXCD, r = total % NXCD, xcd = wgid % NXCD, off = wgid / NXCD; wgid = (xcd < r ? xcd * (q + 1) : r * (q + 1) + (xcd - r) * q) + off; }
        const int per = nM * nN; z = wgid / per; const int w = wgid % per;
        const int nig = WGM * nN, gid = w / nig, fm = gid * WGM, gsz = (nM - fm) < WGM ? (nM - fm) : WGM;
        pm = fm + ((w % nig) % gsz); pn = (w % nig) / gsz; return true;
    }
};
struct GSched {
    Order o; const char* A; const char* B; int n1, n0; unsigned a2, a1, a0, apm, b2, b1, b0, bpn;
    __device__ __forceinline__ const char* baseA() const { return A; }
    __device__ __forceinline__ const char* baseB() const { return B; }
    __device__ __forceinline__ bool next(int i, Unit& u) const {
        int z, pm, pn; if (!o.get(i, z, pm, pn)) return false;
        const int z0 = z % n0, z1 = (z / n0) % n1, z2 = z / (n0 * n1);
        u.z = z; u.pm = pm; u.pn = pn;
        u.ao = z2 * a2 + z1 * a1 + z0 * a0 + pm * apm; u.bo = z2 * b2 + z1 * b1 + z0 * b0 + pn * bpn; return true;
    }
};

template <class Epi, class Sched>
__device__ __forceinline__ void gemm_phase(const int tid, LAS unsigned char* lds, const Sched& S, const Epi& E, const int lda_, const int ldb_, const int nt_) {
    int lda = lda_, ldb = ldb_, nt = nt_; asm volatile("" : "+s"(lda), "+s"(ldb), "+s"(nt));
    const int wid = __builtin_amdgcn_readfirstlane(tid >> 6), lane = tid & 63, wr = wid >> 2, wc = wid & 3, fr = lane & 15, fq = lane >> 4;
    unsigned voffA[2], voffB[2];
#pragma unroll
    for (int i = 0; i < 2; ++i) { int R, C; stage_rc(tid * 16 + i * 8192, R, C); const int Rb = Epi::PERM ? ((R & ~31) + perm32(R & 31)) : R;
        const int Rt = Epi::BMAP ? (64 * (Rb & 63) + (Rb >> 6)) : Rb;
        voffA[i] = (unsigned)(R * lda + C) * 2u; voffB[i] = (unsigned)(Rt * ldb + C) * 2u; }
    const size_t kstep = (size_t)(BK * 2);
    const size_t hstepA = (size_t)HALF * lda * 2, hstepB = (size_t)(Epi::BMAP ? 2 : HALF) * ldb * 2;
    const unsigned ldsw = (unsigned)wid * 1024u;
    const int aoff = lds_byte(wr * 64 + fr, fq * 8), boff = lds_byte(wc * 32 + fr, fq * 8);
#define PG8_SA(b, h) (((b) * 2 + (h)) * HTB)
#define PG8_SB(b, h) ((4 + (b) * 2 + (h)) * HTB)
#define PG8_STAGE(bufoff, gbase, voff) do { _Pragma("unroll") for (int _i = 0; _i < 2; ++_i) \
        __builtin_amdgcn_global_load_lds((const unsigned*)((const char*)(gbase) + (voff)[_i]), (LAS unsigned*)(lds + (bufoff) + ldsw + _i * 8192), 16, 0, 0); } while (0)
#define PG8_LDA(dst, b, h) do { _Pragma("unroll") for (int m = 0; m < 4; ++m) _Pragma("unroll") for (int k = 0; k < 2; ++k) dst[m][k] = *(const LAS bf16x8*)(lds + PG8_SA(b, h) + aoff + m * 2048 + k * 1024); } while (0)
#define PG8_LDB(dst, b, h) do { _Pragma("unroll") for (int n = 0; n < 2; ++n) _Pragma("unroll") for (int k = 0; k < 2; ++k) dst[n][k] = *(const LAS bf16x8*)(lds + PG8_SB(b, h) + boff + n * 2048 + k * 1024); } while (0)
#define PG8_MMA(ai, bj, At, Bt) do { __builtin_amdgcn_s_setprio(1); _Pragma("unroll") for (int m = 0; m < 4; ++m) _Pragma("unroll") for (int n = 0; n < 2; ++n) _Pragma("unroll") for (int k = 0; k < 2; ++k) \
        acc[ai][bj][m][n] = __builtin_amdgcn_mfma_f32_16x16x32_bf16(Bt[n][k], At[m][k], acc[ai][bj][m][n], 0, 0, 0); __builtin_amdgcn_s_setprio(0); } while (0)
#define PG8_WAIT_V(n) asm volatile("s_waitcnt vmcnt(" #n ")" ::: "memory")
#define PG8_WAIT_L(n) asm volatile("s_waitcnt lgkmcnt(" #n ")" ::: "memory")
#define PG8_BAR __builtin_amdgcn_s_barrier()
#define PG8_SCHED __builtin_amdgcn_sched_barrier(0)
    LAS int* ul = (LAS int*)(lds + STAGE_BYTES);
    if (tid < 16) { Unit u; u.ao = 0; u.bo = 0; u.pm = 0; u.pn = 0; u.z = 0; const bool ok = S.next(tid, u);
        ul[tid * 8 + 0] = ok ? 1 : 0; ul[tid * 8 + 1] = (int)u.ao; ul[tid * 8 + 2] = (int)u.bo; ul[tid * 8 + 3] = u.pm; ul[tid * 8 + 4] = u.pn; ul[tid * 8 + 5] = u.z; }
    __syncthreads();
#define PG8_UNIT(i, u, ok) do { const int _i = (i); ok = _i < 16 && __builtin_amdgcn_readfirstlane(ul[(_i & 15) * 8]) != 0; \
        u.ao = (unsigned)__builtin_amdgcn_readfirstlane(ul[(_i & 15) * 8 + 1]); u.bo = (unsigned)__builtin_amdgcn_readfirstlane(ul[(_i & 15) * 8 + 2]); \
        u.pm = __builtin_amdgcn_readfirstlane(ul[(_i & 15) * 8 + 3]); u.pn = __builtin_amdgcn_readfirstlane(ul[(_i & 15) * 8 + 4]); u.z = __builtin_amdgcn_readfirstlane(ul[(_i & 15) * 8 + 5]); } while (0)
    const char* const Abase = S.baseA(); const char* const Bbase = S.baseB();
    Unit cur, nxt; int ui = 0;
    { bool ok0; PG8_UNIT(0, cur, ok0); if (!ok0) return; }
    f32x4 acc[2][2][4][2];
#pragma unroll
    for (int a = 0; a < 2; ++a)
#pragma unroll
        for (int b = 0; b < 2; ++b)
#pragma unroll
            for (int m = 0; m < 4; ++m)
#pragma unroll
                for (int n = 0; n < 2; ++n) acc[a][b][m][n] = (f32x4){0.f, 0.f, 0.f, 0.f};
    bf16x8 At[4][2], B0[2][2], B1[2][2];
    const char* cA = Abase + ((size_t)cur.ao << 8); const char* cB = Bbase + ((size_t)cur.bo << 8);
    PG8_STAGE(PG8_SB(0, 0), cB, voffB); PG8_STAGE(PG8_SA(0, 0), cA, voffA); PG8_STAGE(PG8_SB(0, 1), cB + hstepB, voffB); PG8_STAGE(PG8_SA(0, 1), cA + hstepA, voffA);
    if (wr == 1) PG8_BAR;
    PG8_WAIT_V(4); PG8_BAR;
    PG8_STAGE(PG8_SB(1, 0), cB + kstep, voffB); PG8_STAGE(PG8_SA(1, 0), cA + kstep, voffA); PG8_STAGE(PG8_SB(1, 1), cB + hstepB + kstep, voffB);
    PG8_WAIT_V(6); PG8_BAR;
    for (;;) {
        bool has_next; PG8_UNIT(ui + 1, nxt, has_next);
        const char* nA = has_next ? Abase + ((size_t)nxt.ao << 8) : cA; const char* nB = has_next ? Bbase + ((size_t)nxt.bo << 8) : cB;
        for (int t = 0; t < nt; t += 2) {
            const bool last = (t == nt - 2);
            const char* a1 = cA + (size_t)(t + 1) * kstep;
            const char* a2 = last ? nA : cA + (size_t)(t + 2) * kstep; const char* b2 = last ? nB : cB + (size_t)(t + 2) * kstep;
            const char* a3 = a2 + kstep; const char* b3 = b2 + kstep;
            PG8_LDB(B0, 0, 0); PG8_SCHED; PG8_LDA(At, 0, 0); PG8_STAGE(PG8_SA(1, 1), a1 + hstepA, voffA);
            PG8_WAIT_L(8); PG8_BAR; PG8_WAIT_L(0); PG8_MMA(0, 0, At, B0); PG8_BAR; PG8_SCHED;
            PG8_LDB(B1, 0, 1); PG8_STAGE(PG8_SB(0, 0), b2, voffB);
            PG8_BAR; PG8_WAIT_L(0); PG8_MMA(0, 1, At, B1); PG8_BAR;
            PG8_LDA(At, 0, 1); PG8_STAGE(PG8_SA(0, 0), a2, voffA);
            PG8_BAR; PG8_WAIT_L(0); PG8_MMA(1, 0, At, B0); PG8_BAR; PG8_SCHED;
            PG8_STAGE(PG8_SB(0, 1), b2 + hstepB, voffB);
            PG8_WAIT_V(6); PG8_BAR; PG8_MMA(1, 1, At, B1); PG8_BAR;
            PG8_LDB(B0, 1, 0); PG8_SCHED; PG8_LDA(At, 1, 0); PG8_STAGE(PG8_SA(0, 1), a2 + hstepA, voffA);
            PG8_WAIT_L(8); PG8_BAR; PG8_WAIT_L(0); PG8_MMA(0, 0, At, B0); PG8_BAR; PG8_SCHED;
            PG8_LDB(B1, 1, 1); PG8_STAGE(PG8_SB(1, 0), b3, voffB);
            PG8_BAR; PG8_WAIT_L(0); PG8_MMA(0, 1, At, B1); PG8_BAR;
            PG8_LDA(At, 1, 1); PG8_STAGE(PG8_SA(1, 0), a3, voffA);
            PG8_BAR; PG8_WAIT_L(0); PG8_MMA(1, 0, At, B0); PG8_BAR; PG8_SCHED;
            PG8_STAGE(PG8_SB(1, 1), b3 + hstepB, voffB);
            PG8_WAIT_V(6); PG8_BAR; PG8_MMA(1, 1, At, B1); PG8_BAR;
        }
        E(acc, cur, wr, wc, fr, fq);
        if (!has_next) break;
        if constexpr (!Epi::KEEP_ACC) {
#pragma unroll
            for (int a = 0; a < 2; ++a)
#pragma unroll
                for (int b = 0; b < 2; ++b)
#pragma unroll
                    for (int m = 0; m < 4; ++m)
#pragma unroll
                        for (int n = 0; n < 2; ++n) acc[a][b][m][n] = (f32x4){0.f, 0.f, 0.f, 0.f};
        }
        cur = nxt; cA = nA; cB = nB; ++ui;
    }
    PG8_WAIT_V(0);
    if (wr == 0) PG8_BAR;
    PG8_BAR;
#undef PG8_UNIT
#undef PG8_SA
#undef PG8_SB
#undef PG8_STAGE
#undef PG8_LDA
#undef PG8_LDB
#undef PG8_MMA
#undef PG8_WAIT_V
#undef PG8_WAIT_L
#undef PG8_BAR
#undef PG8_SCHED
}

typedef f32x4 Acc[2][2][4][2];

struct EpiResid {
    static constexpr bool PERM = true, KEEP_ACC = false, BMAP = false;
    const float* base32; const bf16_t* base16; bf16_t* out; const float* gate  ; int row0;
    __device__ __forceinline__ void operator()(Acc& acc, const Unit& u, int wr, int wc, int fr, int fq) const {
        const int rowt = row0 + u.pm * BM, b = rowt / SEQ; const int col0 = u.pn * BM + wc * 32 + 8 * fq;
        f32x4 gv[2][2];
#pragma unroll
        for (int bj = 0; bj < 2; ++bj)
#pragma unroll
            for (int n = 0; n < 2; ++n) gv[bj][n] = *(const f32x4*)(gate + (size_t)b * MODW + col0 + bj * HALF + 4 * n);
        if (base32) {
#pragma unroll
            for (int ai = 0; ai < 2; ++ai)
#pragma unroll
                for (int m = 0; m < 4; ++m) { const size_t off = (size_t)(rowt + ai * HALF + wr * 64 + m * 16 + fr) * DM + col0;
#pragma unroll
                    for (int bj = 0; bj < 2; ++bj) { const f32x4 b0 = *(const f32x4*)(base32 + off + bj * HALF), b1 = *(const f32x4*)(base32 + off + bj * HALF + 4);
                        *(u32x4*)(out + off + bj * HALF) = pack8(b0 + gv[bj][0] * acc[ai][bj][m][0], b1 + gv[bj][1] * acc[ai][bj][m][1]); }
                    asm volatile("" ::: "memory"); }
        } else {
#pragma unroll
            for (int ai = 0; ai < 2; ++ai)
#pragma unroll
                for (int m = 0; m < 4; ++m) { const size_t off = (size_t)(rowt + ai * HALF + wr * 64 + m * 16 + fr) * DM + col0;
#pragma unroll
                    for (int bj = 0; bj < 2; ++bj) { const u32x4 w = *(const u32x4*)(base16 + off + bj * HALF);
                        const f32x4 b0 = {bf_lo(w.x), bf_hi(w.x), bf_lo(w.y), bf_hi(w.y)}, b1 = {bf_lo(w.z), bf_hi(w.z), bf_lo(w.w), bf_hi(w.w)};
                        *(u32x4*)(out + off + bj * HALF) = pack8(b0 + gv[bj][0] * acc[ai][bj][m][0], b1 + gv[bj][1] * acc[ai][bj][m][1]); }
                    asm volatile("" ::: "memory"); }
        }
    }
};
struct EpiBf16 {
    static constexpr bool PERM = true, KEEP_ACC = false, BMAP = false;
    bf16_t* O; int ldo; int zrows;
    __device__ __forceinline__ void operator()(Acc& acc, const Unit& u, int wr, int wc, int fr, int fq) const {
        const int row0 = u.z * zrows + u.pm * BM + wr * 64 + fr, col0 = u.pn * BM + wc * 32 + 8 * fq;
#pragma unroll
        for (int ai = 0; ai < 2; ++ai)
#pragma unroll
            for (int m = 0; m < 4; ++m) { bf16_t* rowp = O + (size_t)(row0 + ai * HALF + m * 16) * ldo + col0;
#pragma unroll
                for (int bj = 0; bj < 2; ++bj) *(u32x4*)(rowp + bj * HALF) = pack8(acc[ai][bj][m][0], acc[ai][bj][m][1]); }
    }
};
struct EpiChanDft {
    static constexpr bool PERM = true, KEEP_ACC = false, BMAP = true;
    bf16_t* Y1;
    __device__ __forceinline__ void operator()(Acc& acc, const Unit& u, int wr, int wc, int fr, int fq) const {
        const int b = u.z & 7, g = u.z >> 3;
#pragma unroll
        for (int ai = 0; ai < 2; ++ai)
#pragma unroll
            for (int m = 0; m < 4; ++m) { const int j = ai * HALF + wr * 64 + m * 16 + fr;
#pragma unroll
                for (int bj = 0; bj < 2; ++bj) { const int s2 = 4 * u.pn + 2 * bj + (wc >> 1), s1 = 32 * (wc & 1) + 8 * fq;
                    *(u32x4*)(Y1 + ((((size_t)(b * DM + g * 256 + j) * 64 + s2) * 2 + u.pm) * 64 + s1)) = pack8(acc[ai][bj][m][0], acc[ai][bj][m][1]); } }
    }
};
struct EpiFftA {
    static constexpr bool PERM = true, KEEP_ACC = false, BMAP = false;
    bf16_t* Y2;
    __device__ __forceinline__ void operator()(Acc& acc, const Unit& u, int wr, int wc, int fr, int fq) const {
        const int b = u.pn >> 8;
#pragma unroll
        for (int mm = 0; mm < 2; ++mm) { const int k1 = 32 * wr + 16 * mm + fr;
#pragma unroll
            for (int bj = 0; bj < 2; ++bj) { const int c = ((u.pn * 4) & 1023) + 2 * bj + (wc >> 1), s20 = 32 * (wc & 1) + 8 * fq; f32x4 yr[2], yi[2];
#pragma unroll
                for (int n = 0; n < 2; ++n)
#pragma unroll
                    for (int e = 0; e < 4; ++e) { const float th = (float)(k1 * (s20 + 4 * n + e)) * (1.0f / 4096.0f); const float cs = __builtin_amdgcn_cosf(th), sn = __builtin_amdgcn_sinf(th);
                        const float re = acc[0][bj][2 * mm][n][e], im = acc[0][bj][2 * mm + 1][n][e]; yr[n][e] = re * cs + im * sn; yi[n][e] = im * cs - re * sn; }
                bf16_t* dst = Y2 + ((((size_t)(b * 64 + k1) * DM + c) * 2) * 64 + s20);
                *(u32x4*)(dst) = pack8(yr[0], yr[1]); *(u32x4*)(dst + 64) = pack8(yi[0], yi[1]); } }
    }
};
struct EpiFftB {
    static constexpr bool PERM = true, KEEP_ACC = false, BMAP = false;
    bf16_t* FO;
    __device__ __forceinline__ void operator()(Acc& acc, const Unit& u, int wr, int wc, int fr, int fq) const {
        if (wr != 0) return;
        const int bk = u.pn >> 2, b = bk >> 6, k1 = bk & 63, c0 = (u.pn & 3) * 256 + wc * 32 + 8 * fq;
#pragma unroll
        for (int m = 0; m < 4; ++m) { const int k2 = 16 * m + fr; bf16_t* rowp = FO + (size_t)(b * SEQ + k1 + 64 * k2) * DM + c0;
#pragma unroll
            for (int bj = 0; bj < 2; ++bj) *(u32x4*)(rowp + bj * HALF) = pack8(acc[0][bj][m][0], acc[0][bj][m][1]); }
    }
};
struct EpiSwiglu {
    static constexpr bool PERM = true, KEEP_ACC = false, BMAP = false;
    bf16_t* O;
    __device__ __forceinline__ void operator()(Acc& acc, const Unit& u, int wr, int wc, int fr, int fq) const {
        const int row0 = u.pm * BM + wr * 64 + fr, col0 = u.pn * HALF + wc * 32 + 8 * fq;
#pragma unroll
        for (int ai = 0; ai < 2; ++ai)
#pragma unroll
            for (int m = 0; m < 4; ++m) { f32x4 v0, v1;
#pragma unroll
                for (int e = 0; e < 4; ++e) { v0[e] = siluf(acc[ai][0][m][0][e]) * acc[ai][1][m][0][e]; v1[e] = siluf(acc[ai][0][m][1][e]) * acc[ai][1][m][1][e]; }
                *(u32x4*)(O + (size_t)(row0 + ai * HALF + m * 16) * DFF + col0) = pack8(v0, v1); }
    }
};
struct EpiQK {
    static constexpr bool PERM = true, KEEP_ACC = false, BMAP = false;
    bf16_t* A2; bf16_t* KTM; const float* rope  ;
    __device__ __forceinline__ void operator()(Acc& acc, const Unit& u, int wr, int wc, int fr, int fq) const {
        const bool isq = u.pn < 4; const int h = isq ? u.pn : u.pn - 4; const int i0 = wc * 32 + 8 * fq;
        const float lgf = lg2gamma(h), lgb = lg2gamma(3 - h);
#pragma unroll
        for (int ai = 0; ai < 2; ++ai)
#pragma unroll
            for (int m = 0; m < 4; ++m) {
                const int tl = u.pm * BM + ai * HALF + wr * 64 + m * 16 + fr, s = tl % SEQ, sl = s % 512;
                const f32x4* rp = (const f32x4*)(rope + ((size_t)s * 128 + i0) * 2);
                f32x4 o1[2], o2[2];
#pragma unroll
                for (int n = 0; n < 2; ++n) { const f32x4 r0 = rp[2 * n], r1 = rp[2 * n + 1]; const f32x4 x1 = acc[ai][0][m][n], x2 = acc[ai][1][m][n];
                    const float cs[4] = {r0[0], r0[2], r1[0], r1[2]}, sn[4] = {r0[1], r0[3], r1[1], r1[3]};
#pragma unroll
                    for (int e = 0; e < 4; ++e) { o1[n][e] = x1[e] * cs[e] - x2[e] * sn[e]; o2[n][e] = x1[e] * sn[e] + x2[e] * cs[e]; } }
                if (isq) {
                    const float df = exp2f((float)(sl + 1) * lgf), db = exp2f((float)(512 - sl) * lgb);
                    bf16_t* rowp = A2 + ((size_t)tl * 4 + h) * 1024 + 512 + i0;
                    *(u32x4*)(rowp) = pack8(o1[0] * df, o1[1] * df); *(u32x4*)(rowp + 128) = pack8(o2[0] * df, o2[1] * df);
                    *(u32x4*)(rowp + 256) = pack8(o1[0] * db, o1[1] * db); *(u32x4*)(rowp + 384) = pack8(o2[0] * db, o2[1] * db);
                } else {
                    bf16_t* rowp = KTM + (size_t)tl * 1024 + h * 256 + i0;
                    *(u32x4*)(rowp) = pack8(o1[0] * 0.0625f, o1[1] * 0.0625f); *(u32x4*)(rowp + 128) = pack8(o2[0] * 0.0625f, o2[1] * 0.0625f);
                }
            }
    }
};
struct EpiKVT {
    static constexpr bool PERM = true, KEEP_ACC = false, BMAP = false;
    bf16_t* KFT; bf16_t* KBT; bf16_t* B2; const float* ropet  ;
    __device__ __forceinline__ void operator()(Acc& acc, const Unit& u, int wr, int wc, int fr, int fq) const {
        if (u.pm < 4) {
            const int h = u.pm; const float lgf = lg2gamma(h), lgb = lg2gamma(3 - h);
#pragma unroll
            for (int bj = 0; bj < 2; ++bj) {
                const int tl0 = u.pn * BM + bj * HALF + wc * 32 + 8 * fq, b = tl0 / SEQ, s0 = tl0 % SEQ, sl0 = s0 % 512;
                f32x4 kfd[2], kbd[2];
#pragma unroll
                for (int n = 0; n < 2; ++n)
#pragma unroll
                    for (int e = 0; e < 4; ++e) { const int sl = sl0 + 4 * n + e; kfd[n][e] = 0.0625f * exp2f((float)(511 - sl) * lgf); kbd[n][e] = 0.0625f * exp2f((float)sl * lgb); }
#pragma unroll
                for (int m = 0; m < 4; ++m) {
                    const int i = wr * 64 + m * 16 + fr;
                    const f32x4* rp = (const f32x4*)(ropet + ((size_t)i * SEQ + s0) * 2);
                    f32x4 o1[2], o2[2];
#pragma unroll
                    for (int n = 0; n < 2; ++n) { const f32x4 r0 = rp[2 * n], r1 = rp[2 * n + 1]; const f32x4 x1 = acc[0][bj][m][n], x2 = acc[1][bj][m][n];
                        const float cs[4] = {r0[0], r0[2], r1[0], r1[2]}, sn[4] = {r0[1], r0[3], r1[1], r1[3]};
#pragma unroll
                        for (int e = 0; e < 4; ++e) { o1[n][e] = x1[e] * cs[e] - x2[e] * sn[e]; o2[n][e] = x1[e] * sn[e] + x2[e] * cs[e]; } }
                    const size_t r1off = ((size_t)(b * 4 + h) * 256 + i) * SEQ + s0, r2off = r1off + (size_t)128 * SEQ;
                    *(u32x4*)(KFT + r1off) = pack8(o1[0] * kfd[0], o1[1] * kfd[1]); *(u32x4*)(KFT + r2off) = pack8(o2[0] * kfd[0], o2[1] * kfd[1]);
                    *(u32x4*)(KBT + r1off) = pack8(o1[0] * kbd[0], o1[1] * kbd[1]); *(u32x4*)(KBT + r2off) = pack8(o2[0] * kbd[0], o2[1] * kbd[1]);
                }
            }
        } else {
            const int h = (u.pm - 4) >> 1, dv0 = ((u.pm - 4) & 1) * 256;
#pragma unroll
            for (int bj = 0; bj < 2; ++bj) {
                const int tl0 = u.pn * BM + bj * HALF + wc * 32 + 8 * fq, b = tl0 / SEQ, s0 = tl0 % SEQ, np = s0 / 512, sl0 = s0 % 512;
#pragma unroll
                for (int ai = 0; ai < 2; ++ai)
#pragma unroll
                    for (int m = 0; m < 4; ++m) { const int dv = dv0 + ai * HALF + wr * 64 + m * 16 + fr;
                        *(u32x4*)(B2 + (((size_t)((b * 4 + h) * 8 + np) * 512 + dv) * 1024 + sl0)) = pack8(acc[ai][bj][m][0], acc[ai][bj][m][1]); }
            }
        }
    }
};
struct EpiScores {
    static constexpr bool PERM = true, KEEP_ACC = false, BMAP = false;
    bf16_t* A2;
    __device__ __forceinline__ void operator()(Acc& acc, const Unit& u, int wr, int wc, int fr, int fq) const {
        const int np = u.z % 8, h = (u.z / 8) % 4, b = u.z / 32; const float lgf = lg2gamma(h), lgb = lg2gamma(3 - h);
#pragma unroll
        for (int ai = 0; ai < 2; ++ai)
#pragma unroll
            for (int m = 0; m < 4; ++m) { const int t = u.pm * BM + ai * HALF + wr * 64 + m * 16 + fr; const float tf = -(float)(t + 1) * lgf;
                bf16_t* rowp = A2 + ((size_t)(b * SEQ + np * 512 + t) * 4 + h) * 1024;
#pragma unroll
                for (int bj = 0; bj < 2; ++bj) { const int s0 = u.pn * BM + bj * HALF + wc * 32 + 8 * fq; f32x4 v[2];
#pragma unroll
                    for (int n = 0; n < 2; ++n)
#pragma unroll
                        for (int e = 0; e < 4; ++e) { const int s = s0 + 4 * n + e; const float ex = (s <= t) ? -(float)(s + 1) * lgf : (float)(s - t) * lgb + tf; v[n][e] = acc[ai][bj][m][n][e] * exp2f(ex); }
                    *(u32x4*)(rowp + s0) = pack8(v[0], v[1]); } }
    }
};
struct EpiState {
    static constexpr bool PERM = true, KEEP_ACC = false, BMAP = false;
    bf16_t* B2;
    __device__ __forceinline__ void operator()(Acc& acc, const Unit& u, int wr, int wc, int fr, int fq) const {
        const int dvh = u.z & 1, slot = (u.z >> 1) & 7, dir = (u.z >> 4) & 1, bh = u.z >> 5;
        const int col0 = 512 + dir * 256 + wc * 32 + 8 * fq;
#pragma unroll
        for (int ai = 0; ai < 2; ++ai)
#pragma unroll
            for (int m = 0; m < 4; ++m) { const int dv = dvh * 256 + ai * HALF + wr * 64 + m * 16 + fr;
                bf16_t* rowp = B2 + ((size_t)(bh * 8 + slot) * 512 + dv) * 1024 + col0;
#pragma unroll
                for (int bj = 0; bj < 2; ++bj) *(u32x4*)(rowp + bj * HALF) = pack8(acc[ai][bj][m][0], acc[ai][bj][m][1]); }
    }
};
struct StateSched {
    const char* B2; const char* KFT; int G, c;
    __device__ __forceinline__ const char* baseA() const { return B2; }
    __device__ __forceinline__ const char* baseB() const { return KFT; }
    __device__ __forceinline__ bool next(int i, Unit& u) const {
        const int L = i * G + c; if (L >= 448) return false;
        const int dvh = L & 1, t = L >> 1, cidx = t % 7, t2 = t / 7, dir = t2 & 1, bh = t2 >> 1;
        const int ci = dir ? 7 - cidx : cidx, slot = dir ? ci - 1 : ci + 1;
        u.pm = 0; u.pn = 0; u.z = ((bh * 2 + dir) * 8 + slot) * 2 + dvh;
        u.ao = (unsigned)(((bh * 8 + ci) * 512 + dvh * 256) * 8);
        u.bo = (unsigned)(dir * 131072 + bh * 256 * 32 + ci * 4);
        return true;
    }
};
struct EpiRetOut {
    static constexpr bool PERM = true, KEEP_ACC = false, BMAP = false;
    bf16_t* Y; float* stats;
    __device__ __forceinline__ void operator()(Acc& acc, const Unit& u, int wr, int wc, int fr, int fq) const {
        const int np = u.z % 8, h = (u.z / 8) % 4, b = u.z / 32;
#pragma unroll
        for (int ai = 0; ai < 2; ++ai)
#pragma unroll
            for (int m = 0; m < 4; ++m) { const int tl = b * SEQ + np * 512 + u.pm * BM + ai * HALF + wr * 64 + m * 16 + fr;
                float s = 0.f, q = 0.f;
#pragma unroll
                for (int bj = 0; bj < 2; ++bj)
#pragma unroll
                    for (int n = 0; n < 2; ++n) { const f32x4 x = acc[ai][bj][m][n]; s += (x[0] + x[1]) + (x[2] + x[3]); q += (x[0] * x[0] + x[1] * x[1]) + (x[2] * x[2] + x[3] * x[3]); }
                s += __shfl_xor(s, 16); s += __shfl_xor(s, 32); q += __shfl_xor(q, 16); q += __shfl_xor(q, 32);
                if (fq == 0) *(f32x2*)(stats + (((size_t)tl * 4 + h) * 8 + u.pn * 4 + wc) * 2) = (f32x2){s, q};
                bf16_t* rowp = Y + (size_t)tl * 2048 + h * 512 + u.pn * BM + wc * 32 + 8 * fq;
#pragma unroll
                for (int bj = 0; bj < 2; ++bj) *(u32x4*)(rowp + bj * HALF) = pack8(acc[ai][bj][m][0], acc[ai][bj][m][1]); }
    }
};
struct EpiGate {
    static constexpr bool PERM = true, KEEP_ACC = false, BMAP = false;
    bf16_t* Y; const float* stats;
    __device__ __forceinline__ void operator()(Acc& acc, const Unit& u, int wr, int wc, int fr, int fq) const {
        const int h = u.pn >> 1;
#pragma unroll
        for (int ai = 0; ai < 2; ++ai)
#pragma unroll
            for (int m = 0; m < 4; ++m) { const int tl = u.pm * BM + ai * HALF + wr * 64 + m * 16 + fr;
                const f32x4* sp = (const f32x4*)(stats + ((size_t)tl * 4 + h) * 16); float s = 0.f, q = 0.f;
#pragma unroll
                for (int k = 0; k < 4; ++k) { const f32x4 v = sp[k]; s += v[0] + v[2]; q += v[1] + v[3]; }
                const float mu = s * (1.0f / 512.0f), var = fmaxf(q * (1.0f / 512.0f) - mu * mu, 0.f), rstd = rsqrtf(var + 1e-6f);
                bf16_t* rowp = Y + (size_t)tl * 2048 + u.pn * BM + wc * 32 + 8 * fq;
#pragma unroll
                for (int bj = 0; bj < 2; ++bj) { const u32x4 yw = *(const u32x4*)(rowp + bj * HALF);
                    const float yv[8] = {bf_lo(yw.x), bf_hi(yw.x), bf_lo(yw.y), bf_hi(yw.y), bf_lo(yw.z), bf_hi(yw.z), bf_lo(yw.w), bf_hi(yw.w)};
                    f32x4 v0, v1;
#pragma unroll
                    for (int e = 0; e < 4; ++e) { v0[e] = siluf(acc[ai][bj][m][0][e]) * (yv[e] - mu) * rstd; v1[e] = siluf(acc[ai][bj][m][1][e]) * (yv[4 + e] - mu) * rstd; }
                    *(u32x4*)(rowp + bj * HALF) = pack8(v0, v1); }
                asm volatile("" ::: "memory"); }
    }
};

template <int MODE>
__device__ __forceinline__ void conv_weight(const int tid, const float* W, int K, int N, bf16_t* WT, int bx, int G) {
    const int nitems = (K >> 3) * N;
#pragma unroll 2
    for (int idx = bx * 512 + tid; idx < nitems; idx += G * 512) {
        const int n = idx % N, k0 = (idx / N) * 8; float v[8];
#pragma unroll
        for (int e = 0; e < 8; ++e) v[e] = W[(size_t)(k0 + e) * N + n];
        int nn = n;
        if (MODE == 1) { const int j = nn < DFF ? nn : nn - DFF; nn = 256 * (j >> 7) + (nn < DFF ? 0 : 128) + (j & 127); }
        u32x4 w; w.x = cvt_pk_bf16(v[0], v[1]); w.y = cvt_pk_bf16(v[2], v[3]); w.z = cvt_pk_bf16(v[4], v[5]); w.w = cvt_pk_bf16(v[6], v[7]);
        *(u32x4*)(WT + (size_t)nn * K + k0) = w;
    }
}
template <bool IN16, bool FINAL>
__device__ __forceinline__ void norm_rows(const int tid, const int bx, const int G, const float* x32, const bf16_t* x16, const float* g, const float* mod, int shoff, int scoff, bf16_t* h, float* outf) {
    const int lane = tid & 63, gw = bx * 8 + (tid >> 6), nw = G * 8;
#pragma unroll 2
    for (int r = gw; r < NTOK; r += nw) {
        const int b = r / SEQ; f32x4 v[2][2]; float ss = 0.f;
#pragma unroll
        for (int j = 0; j < 2; ++j) { const size_t off = (size_t)r * DM + j * 512 + lane * 8;
            if (IN16) { const u32x4 w = *(const u32x4*)(x16 + off); v[j][0] = (f32x4){bf_lo(w.x), bf_hi(w.x), bf_lo(w.y), bf_hi(w.y)}; v[j][1] = (f32x4){bf_lo(w.z), bf_hi(w.z), bf_lo(w.w), bf_hi(w.w)}; }
            else { v[j][0] = *(const f32x4*)(x32 + off); v[j][1] = *(const f32x4*)(x32 + off + 4); }
#pragma unroll
            for (int q = 0; q < 2; ++q) ss += (v[j][q][0] * v[j][q][0] + v[j][q][1] * v[j][q][1]) + (v[j][q][2] * v[j][q][2] + v[j][q][3] * v[j][q][3]); }
#pragma unroll
        for (int o = 32; o >= 1; o >>= 1) ss += __shfl_xor(ss, o);
        const float rs = rsqrtf(ss * (1.0f / 1024.0f) + 1e-6f);
#pragma unroll
        for (int j = 0; j < 2; ++j) { const int col = j * 512 + lane * 8; f32x4 y[2];
#pragma unroll
            for (int q = 0; q < 2; ++q) { const f32x4 gg = *(const f32x4*)(g + col + 4 * q), sc = *(const f32x4*)(mod + (size_t)b * MODW + scoff + col + 4 * q), sh = *(const f32x4*)(mod + (size_t)b * MODW + shoff + col + 4 * q);
                y[q] = (v[j][q] * rs) * gg * (sc + 1.0f) + sh; }
            if (FINAL) { *(f32x4*)(outf + (size_t)r * DM + col) = y[0]; *(f32x4*)(outf + (size_t)r * DM + col + 4) = y[1]; }
            else *(u32x4*)(h + (size_t)r * DM + col) = pack8(y[0], y[1]); }
    }
}

#define XB_TMO      128
#define XB_XCNT(j)  (256  + 64 * (j))
#define XB_XSUB(j)  (1280 + 64 * (j))
#define XB_XGEN(j)  (2304 + 64 * (j))
#define XB_TOP      3328
#define XB_TOPGEN   3392
#define XCD_BAR_WORDS 3456
#define XB_SPIN_CAP (1u << 18)
__device__ __forceinline__ unsigned xb_ld(unsigned* p)              { return __hip_atomic_load(p, __ATOMIC_RELAXED, __HIP_MEMORY_SCOPE_AGENT); }
__device__ __forceinline__ unsigned xb_add(unsigned* p, unsigned v) { return __hip_atomic_fetch_add(p, v, __ATOMIC_RELAXED, __HIP_MEMORY_SCOPE_AGENT); }
__device__ __forceinline__ unsigned xb_xcc_id() { return (unsigned)__builtin_amdgcn_s_getreg((3 << 11) | 20) & 0xFu; }
#define XB_SPIN(cond, bar) do { unsigned _sp = 0; while (cond) { __builtin_amdgcn_s_sleep(1); \
    if ((++_sp & 255u) == 0u) { if (xb_ld(&(bar)[XB_TMO])) break; if (_sp > XB_SPIN_CAP) { atomicAdd(&(bar)[XB_TMO], 1u); break; } } } } while (0)
__device__ __forceinline__ void xcd_barrier_complete(unsigned* bar, unsigned x, unsigned& nloc, unsigned& nx) {
    const unsigned G = gridDim.x * gridDim.y * gridDim.z;
    unsigned sum, cnt, mine, sp = 0u;
    for (;;) {
        sum = 0u; cnt = 0u; mine = 0u;
#pragma unroll
        for (unsigned j = 0; j < 16; ++j) { const unsigned c = xb_ld(&bar[XB_XCNT(j)]); sum += c; cnt += (c > 0u) ? 1u : 0u; mine = (j == x) ? c : mine; }
        if (sum == G) break;
        __builtin_amdgcn_s_sleep(1);
        if ((++sp & 255u) == 0u) { if (xb_ld(&bar[XB_TMO])) break; if (sp > XB_SPIN_CAP) { atomicAdd(&bar[XB_TMO], 1u); break; } }
    }
    nloc = mine > 0u ? mine : 1u; nx = cnt > 0u ? cnt : 1u;
}
__device__ __forceinline__ void xcd_barrier(unsigned* bar, volatile LAS unsigned* st, const int tid) {
    asm volatile("s_waitcnt vmcnt(0)" ::: "memory");
    __syncthreads();
    if (tid == 0) {
        const unsigned x = xb_xcc_id();
        __builtin_amdgcn_s_waitcnt(0);
        unsigned nloc = st[0], nx = st[1];
        if (nloc == 0u) { xcd_barrier_complete(bar, x, nloc, nx); st[0] = nloc; st[1] = nx; }
        const unsigned old = xb_add(&bar[XB_XSUB(x)], 1u);
        const unsigned gen = old / nloc;
        if (old + 1u == (gen + 1u) * nloc) {
            __builtin_amdgcn_fence(__ATOMIC_RELEASE, "agent");
            asm volatile("s_waitcnt vmcnt(0)" ::: "memory");
            const unsigned og = xb_add(&bar[XB_TOP], 1u);
            const unsigned tg = og / nx;
            if (og + 1u == (tg + 1u) * nx) xb_add(&bar[XB_TOPGEN], 1u);
            else XB_SPIN(xb_ld(&bar[XB_TOPGEN]) == tg, bar);
            __builtin_amdgcn_fence(__ATOMIC_ACQUIRE, "agent");
            xb_add(&bar[XB_XGEN(x)], 1u);
            asm volatile("s_waitcnt vmcnt(0)" ::: "memory");
        } else {
            XB_SPIN(xb_ld(&bar[XB_XGEN(x)]) == gen, bar);
            __builtin_amdgcn_fence(__ATOMIC_ACQUIRE, "agent");
            asm volatile("s_waitcnt vmcnt(0)" ::: "memory");
        }
    }
    __syncthreads();
}

struct Params { const float* in[14]; float* out; unsigned char* ws; int ph_lo, ph_hi; };

enum { K_GEMV = 0, K_MODFIN, K_PREP, K_F1, K_FA, K_FB, K_N2, K_FF1, K_RESID, K_P1, K_P2S, K_PFX, K_P5, K_GATE, K_FINAL };
enum { R_F3 = 0, R_WOUT, R_FF2 };

__device__ __forceinline__ void plain_sched(GSched& S, int nM, int nN, int G, int c, const void* A, const void* B, int lda, int ldb) {
    S.o.init(nM, nN, 1, G, c); S.A = (const char*)A; S.B = (const char*)B; S.n1 = 1; S.n0 = 1;
    S.a2 = 0; S.a1 = 0; S.a0 = 0; S.apm = (unsigned)(2 * lda); S.b2 = 0; S.b1 = 0; S.b0 = 0; S.bpn = (unsigned)(2 * ldb);
}

__global__ void __launch_bounds__(512, 2) mega(Params p) {
    extern __shared__ __attribute__((aligned(16))) unsigned char shm[];
    {   volatile LAS unsigned* st0 = (volatile LAS unsigned*)((LAS unsigned char*)shm + STAGE_BYTES + 768);
        if (threadIdx.x == 0) { st0[0] = 0u; st0[1] = 0u; }
        __syncthreads();
        if (p.ph_lo == 0 && blockIdx.x == 0) { unsigned* bw = (unsigned*)(p.ws + WS_BAR); for (int i = threadIdx.x; i < XCD_BAR_WORDS; i += 512) bw[i] = 0u; }
    }
    for (int pph = p.ph_lo; pph < p.ph_hi; ++pph) {
        int ph = pph;
        if (PROBE_NDUP > 0) { const int dups[] = {PROBE_DUPS}; int sub = 0;
#pragma unroll
            for (int i = 0; i < PROBE_NDUP; ++i) sub += (dups[i] + i + 1 <= pph) ? 1 : 0;
            ph = pph - sub; }
        int tid_ = threadIdx.x, G_ = gridDim.x, bx_ = blockIdx.x; unsigned char* ws_ = p.ws; float* xres_ = p.out; unsigned ldsa = 0;
        asm volatile("" : "+v"(tid_), "+s"(G_), "+s"(bx_), "+s"(ldsa));
        const int tid = tid_, lane = tid & 63, wid = tid >> 6, G = G_, bx = bx_; unsigned char* const ws = ws_; float* const xres = xres_;
        LAS unsigned char* const lds = (LAS unsigned char*)shm + ldsa;
        int kind, l = 0, half = 0, rk = 0;
        if (ph < 2) kind = ph;
        else if (ph == 50) kind = K_FINAL;
        else {
            const int q = ph - 2, pair = q / 24, r = q % 24;
            if (r < 8) { l = 2 * pair; kind = r == 0 ? K_PREP : r == 1 ? K_F1 : r == 2 ? K_FA : r == 3 ? K_FB : r == 4 ? K_RESID : r == 5 ? K_N2 : r == 6 ? K_FF1 : K_RESID; rk = r == 4 ? R_F3 : R_FF2; }
            else { l = 2 * pair + 1; const int r2 = r - 8;
                if (r2 == 0) kind = K_PREP;
                else if (r2 <= 12) { half = (r2 - 1) / 6; const int sub = (r2 - 1) % 6; kind = sub == 0 ? K_P1 : sub == 1 ? K_P2S : sub == 2 ? K_PFX : sub == 3 ? K_P5 : sub == 4 ? K_GATE : K_RESID; rk = R_WOUT; }
                else { kind = r2 == 13 ? K_N2 : r2 == 14 ? K_FF1 : K_RESID; rk = R_FF2; } }
        }
        float* MOD = (float*)(ws + WS_MOD);
        const float* modl = MOD + l * 6144;
        bf16_t* const H = (bf16_t*)((unsigned char*)xres + 64 * MiB);
        bf16_t* const X16 = (bf16_t*)(ws + WS_H);
        switch (kind) {
        case K_GEMV: {
            const float* c_in = p.in[1]; const float* w_ada = p.in[2]; const float* w_ada_f = p.in[12];
            float* MODP = (float*)(ws + WS_MODP); float* ROPE = (float*)(ws + WS_ROPE); float* ROPET = (float*)(ws + WS_ROPET); bf16_t* CS = (bf16_t*)(ws + WS_CS);
            LAS float* cact = (LAS float*)lds;
            for (int i = tid; i < 8 * DM; i += 512) { const float v = c_in[i]; cact[i] = v / (1.0f + __expf(-v)); }
            __syncthreads();
            int vz = 0; asm volatile("" : "+v"(vz));
#pragma unroll 1
            for (int w = bx * 8 + wid; w < 104 * 16; w += G * 8) {
                const int cgp = w % 104, ks = w / 104, gc = cgp * 256 + lane * 4;
                const float* Wp; int ldw;
                if (gc < 24576) { const int ll = gc / 6144; Wp = w_ada + (size_t)ll * DM * 6144 + (gc - ll * 6144); ldw = 6144; } else { Wp = w_ada_f + (gc - 24576); ldw = 2048; }
                f32x4 a[8];
#pragma unroll
                for (int b = 0; b < 8; ++b) a[b] = (f32x4){0.f, 0.f, 0.f, 0.f};
#pragma unroll 4
                for (int k = ks * 64; k < ks * 64 + 64; ++k) { const f32x4 wv = *(const f32x4*)(Wp + (size_t)k * ldw);
#pragma unroll
                    for (int b = 0; b < 8; ++b) a[b] += wv * cact[b * DM + k + vz]; }
#pragma unroll
                for (int b = 0; b < 8; ++b) *(f32x4*)(MODP + ((size_t)(ks * 8 + b)) * MODW + gc) = a[b];
            }
#pragma unroll 1
            for (int idx = bx * 512 + tid; idx < SEQ * 128; idx += G * 512) {
                const int s = idx >> 7, i = idx & 127;
                const float invf = exp2f(-(float)i * (13.287712379549449f / 128.0f));
                const float ang = (float)s * invf;
                const double rev = (double)ang * 0.15915494309189535; const float fr_ = (float)(rev - floor(rev));
                const float sn = __builtin_amdgcn_sinf(fr_), cs = __builtin_amdgcn_cosf(fr_);
                *(f32x2*)(ROPE + (size_t)idx * 2) = (f32x2){cs, sn};
                *(f32x2*)(ROPET + ((size_t)i * SEQ + s) * 2) = (f32x2){cs, sn};
            }
#pragma unroll 1
            for (int idx = bx * 512 + tid; idx < 512 * 256; idx += G * 512) {
                const int row = idx >> 8, d = idx & 255, j = row & 255, part = row >> 8; const float fr_ = (float)((j * d) & 255) * (1.0f / 256.0f);
                const float v = (part ? __builtin_amdgcn_sinf(fr_) : __builtin_amdgcn_cosf(fr_)) * 0.0625f;
                CS[idx] = (bf16_t)(cvt_pk_bf16(v, 0.f) & 0xffffu);
            }
            {   bf16_t* TA = (bf16_t*)(ws + WS_TA); bf16_t* TB = (bf16_t*)(ws + WS_TB);
#pragma unroll 1
                for (int idx = bx * 512 + tid; idx < 256 * 128; idx += G * 512) {
                    const int row = idx >> 7, kk = idx & 127, pin = kk >> 6, sx = kk & 63;
                    float va = 0.f, vb = 0.f;
                    if (row < 128) { const int wr_ = row >> 6, m_ = (row >> 4) & 3, fr_ = row & 15, k1 = 32 * wr_ + 16 * (m_ >> 1) + fr_, pout = m_ & 1; const float th = (float)((k1 * sx) & 63) * (1.0f / 64.0f);
                        const float cs = __builtin_amdgcn_cosf(th), sn = __builtin_amdgcn_sinf(th); va = (pout == 0 ? (pin == 0 ? cs : -sn) : (pin == 0 ? -sn : -cs)) * 0.125f; }
                    if (row < 64) { const float th = (float)((row * sx) & 63) * (1.0f / 64.0f); vb = (pin == 0 ? __builtin_amdgcn_cosf(th) : __builtin_amdgcn_sinf(th)) * 0.125f; }
                    TA[idx] = (bf16_t)(cvt_pk_bf16(va, 0.f) & 0xffffu); TB[idx] = (bf16_t)(cvt_pk_bf16(vb, 0.f) & 0xffffu);
                } }
        } break;
        case K_MODFIN: {
            const float* b_ada = p.in[3]; const float* b_ada_f = p.in[13]; const float* MODP = (const float*)(ws + WS_MODP);
#pragma unroll 1
            for (int idx = bx * 512 + tid; idx < 8 * MODW; idx += G * 512) {
                const int b = idx / MODW, gc = idx % MODW; float s = gc < 24576 ? b_ada[gc] : b_ada_f[gc - 24576];
#pragma unroll
                for (int ks = 0; ks < 16; ++ks) s += MODP[((size_t)(ks * 8 + b)) * MODW + gc];
                MOD[idx] = s;
            }
        } break;
        case K_PREP: {
            const bool fourier = (l & 1) == 0; const int j = l >> 1;
            if (fourier) {
                conv_weight<0>(tid, p.in[6] + (size_t)j * DM * DM, DM, DM, (bf16_t*)(ws + W_MIXIN), bx, G);
            } else {
                conv_weight<0>(tid, p.in[7] + (size_t)j * DM * 6144, DM, 6144, (bf16_t*)(ws + W_MIXIN), bx, G);
                conv_weight<0>(tid, p.in[8] + (size_t)j * 2048 * DM, 2048, DM, (bf16_t*)(ws + W_MIXOUT), bx, G);
            }
            conv_weight<1>(tid, p.in[9] + (size_t)l * DM * 2 * DFF, DM, 2 * DFF, (bf16_t*)(ws + W_FFNIN), bx, G);
            conv_weight<0>(tid, p.in[10] + (size_t)l * DFF * DM, DFF, DM, (bf16_t*)(ws + W_FFNOUT), bx, G);
            __syncthreads();
            if (l == 0) norm_rows<false, false>(tid, bx, G, p.in[0], nullptr, p.in[4] + l * DM, modl, 0, 1024, H, nullptr);
            else norm_rows<true, false>(tid, bx, G, nullptr, X16, p.in[4] + l * DM, modl, 0, 1024, H, nullptr);
        } break;
        case K_F1: {
            GSched S; S.o.init(2, 16, 32, G, bx); S.A = (const char*)(ws + WS_CS); S.B = (const char*)H; S.n1 = 4; S.n0 = 8;
            S.a2 = 0; S.a1 = 0; S.a0 = 0; S.apm = 2 * 256; S.b2 = 0; S.b1 = 2; S.b0 = SEQ * 8; S.bpn = 4 * 8;
            EpiChanDft E{(bf16_t*)(ws + WS_Y1)};
            gemm_phase(tid, lds, S, E, 256, DM, 4);
        } break;
        case K_FA: {
            GSched S; plain_sched(S, 1, 2048, G, bx, ws + WS_TA, ws + WS_Y1, 128, 128);
            EpiFftA E{(bf16_t*)(ws + WS_Y2)};
            gemm_phase(tid, lds, S, E, 128, 128, 2);
        } break;
        case K_FB: {
            GSched S; plain_sched(S, 1, 2048, G, bx, ws + WS_TB, ws + WS_Y2, 128, 128);
            EpiFftB E{(bf16_t*)(ws + WS_FO)};
            gemm_phase(tid, lds, S, E, 128, 128, 2);
        } break;
        case K_N2: {
            norm_rows<true, false>(tid, bx, G, nullptr, X16, p.in[5] + l * DM, modl, 3072, 4096, H, nullptr);
        } break;
        case K_FF1: {
            GSched S; plain_sched(S, 128, 22, G, bx, H, ws + W_FFNIN, DM, DM);
            EpiSwiglu E{(bf16_t*)(ws + WS_HID)};
            gemm_phase(tid, lds, S, E, DM, DM, 16);
        } break;
        case K_RESID: {
            GSched S; EpiResid E; int ld, nt;
            if (rk == R_F3) { ld = DM; nt = 16; plain_sched(S, 128, 4, G, bx, ws + WS_FO, ws + W_MIXIN, ld, ld); E = EpiResid{l == 0 ? p.in[0] : nullptr, X16, X16, modl + 2048, 0}; }
            else if (rk == R_WOUT) { ld = 2048; nt = 32; plain_sched(S, 64, 4, G, bx, ws + WS_Y, ws + W_MIXOUT, ld, ld); E = EpiResid{nullptr, X16, X16, modl + 2048, half * HTOK}; }
            else { ld = DFF; nt = 44; plain_sched(S, 128, 4, G, bx, ws + WS_HID, ws + W_FFNOUT, ld, ld); E = EpiResid{nullptr, X16, X16, modl + 5120, 0}; }
            gemm_phase(tid, lds, S, E, ld, ld, nt);
        } break;
        case K_P1: {
            const bf16_t* Hh = H + (size_t)half * HTOK * DM; const bf16_t* WTin = (const bf16_t*)(ws + W_MIXIN);
            { GSched S; plain_sched(S, 64, 8, G, bx, Hh, WTin, DM, DM);
              EpiQK E{(bf16_t*)(ws + WS_A2), (bf16_t*)(ws + WS_KTM), (const float*)(ws + WS_ROPE)};
              gemm_phase(tid, lds, S, E, DM, DM, 16); }
            { GSched S; plain_sched(S, 12, 64, G, bx, WTin + (size_t)1024 * DM, Hh, DM, DM);
              EpiKVT E{(bf16_t*)(ws + WS_KFT), (bf16_t*)(ws + WS_KBT), (bf16_t*)(ws + WS_B2), (const float*)(ws + WS_ROPET)};
              gemm_phase(tid, lds, S, E, DM, DM, 16); }
        } break;
        case K_P2S: {
            bf16_t* A2 = (bf16_t*)(ws + WS_A2); bf16_t* B2 = (bf16_t*)(ws + WS_B2);
            { StateSched S{(const char*)B2, (const char*)(ws + WS_KFT), G, bx};
              EpiState E{B2};
              gemm_phase(tid, lds, S, E, 1024, SEQ, 8); }
            { GSched S; S.o.init(2, 2, 128, G, G - 1 - bx); S.A = (const char*)(A2 + 512); S.B = (const char*)(ws + WS_KTM); S.n1 = 4; S.n0 = 8;
              S.a2 = SEQ * 32; S.a1 = 8; S.a0 = 512 * 32; S.apm = 256 * 32;
              S.b2 = SEQ * 8; S.b1 = 2; S.b0 = 512 * 8; S.bpn = 256 * 8;
              EpiScores E{A2};
              gemm_phase(tid, lds, S, E, 4096, DM, 4); }
        } break;
        case K_PFX: {
            bf16_t* B2 = (bf16_t*)(ws + WS_B2);
#pragma unroll 1
            for (int it = bx * 512 + tid; it < 16 * 512 * 64; it += G * 512) {
                const int c8 = it & 63, dv = (it >> 6) & 511, bh = it >> 15, dir = c8 >> 5, h = bh & 3;
                const float dec = exp2f(512.0f * lg2gamma(dir ? 3 - h : h));
                bf16_t* p0 = B2 + ((size_t)(bh * 8) * 512 + dv) * 1024 + 512 + c8 * 8;
                float R[8];
#pragma unroll
                for (int e = 0; e < 8; ++e) R[e] = 0.f;
                u32x4 sv[7];
#pragma unroll
                for (int k = 0; k < 7; ++k) { const int slot = dir ? 6 - k : k + 1; sv[k] = *(const u32x4*)(p0 + (size_t)slot * 512 * 1024); }
                { unsigned zz = 0; asm volatile("" : "+v"(zz)); *(u32x4*)(p0 + (size_t)(dir ? 7 : 0) * 512 * 1024) = (u32x4){zz, zz, zz, zz}; }
#pragma unroll
                for (int k = 0; k < 7; ++k) { const int slot = dir ? 6 - k : k + 1; const u32x4 w = sv[k];
                    const float s[8] = {bf_lo(w.x), bf_hi(w.x), bf_lo(w.y), bf_hi(w.y), bf_lo(w.z), bf_hi(w.z), bf_lo(w.w), bf_hi(w.w)};
#pragma unroll
                    for (int e = 0; e < 8; ++e) R[e] = R[e] * dec + s[e];
                    u32x4 o; o.x = cvt_pk_bf16(R[0], R[1]); o.y = cvt_pk_bf16(R[2], R[3]); o.z = cvt_pk_bf16(R[4], R[5]); o.w = cvt_pk_bf16(R[6], R[7]);
                    *(u32x4*)(p0 + (size_t)slot * 512 * 1024) = o; }
            }
        } break;
        case K_P5: {
            GSched S; S.o.init(2, 2, 128, G, bx); S.A = (const char*)(ws + WS_A2); S.B = (const char*)(ws + WS_B2); S.n1 = 4; S.n0 = 8;
            S.a2 = SEQ * 32; S.a1 = 8; S.a0 = 512 * 32; S.apm = 256 * 32;
            S.b2 = 32 * 512 * 8; S.b1 = 8 * 512 * 8; S.b0 = 512 * 8; S.bpn = 256 * 8;
            EpiRetOut E{(bf16_t*)(ws + WS_Y), (float*)(ws + WS_STATS)};
            gemm_phase(tid, lds, S, E, 4096, 1024, 16);
        } break;
        case K_GATE: {
            GSched S; plain_sched(S, 64, 8, G, bx, H + (size_t)half * HTOK * DM, (const bf16_t*)(ws + W_MIXIN) + (size_t)4096 * DM, DM, DM);
            EpiGate E{(bf16_t*)(ws + WS_Y), (const float*)(ws + WS_STATS)};
            gemm_phase(tid, lds, S, E, DM, DM, 16);
        } break;
        default: {
            norm_rows<true, true>(tid, bx, G, nullptr, X16, p.in[11], MOD + 24576, 0, 1024, nullptr, xres);
        } break;
        }
        if (pph + 1 < p.ph_hi) {
            if (pph == p.ph_lo) { cg::this_grid().sync();
                if (tid == 0) (void)xb_add(&((unsigned*)(ws + WS_BAR))[XB_XCNT(xb_xcc_id())], 1u); }
            else xcd_barrier((unsigned*)(ws + WS_BAR), (volatile LAS unsigned*)(lds + STAGE_BYTES + 768), tid);
        }
    }
}
constexpr int N_PHASES = 2 + 2 * (1 + 4 + 3) + 2 * (1 + 12 + 3) + 1 + PROBE_NDUP;

extern "C" void kernel_launch(void* const* d_in, const int* in_sizes, int n_in, void* d_out, int out_size, void* d_ws, size_t ws_size, hipStream_t stream) {
    static int grid = 0;
    if (grid == 0) {
        if (n_in != 14 || ws_size < WS_END) { fprintf(stderr, "kernel_launch: unexpected n_in %d or ws_size %zu (< %zu)\n", n_in, ws_size, (size_t)WS_END); grid = -1; return; }
        int dev = 0, cus = 0, per_cu = 0;
        hipGetDevice(&dev); hipDeviceGetAttribute(&cus, hipDeviceAttributeMultiprocessorCount, dev);
        if (hipFuncSetAttribute((const void*)mega, hipFuncAttributeMaxDynamicSharedMemorySize, LDS_BYTES) != hipSuccess) { fprintf(stderr, "kernel_launch: hipFuncSetAttribute failed\n"); grid = -1; return; }
        hipOccupancyMaxActiveBlocksPerMultiprocessor(&per_cu, (const void*)mega, 512, LDS_BYTES);
        (void)hipGetLastError();
        if (per_cu < 1) { fprintf(stderr, "kernel_launch: occupancy query says %d blocks per CU\n", per_cu); per_cu = 1; }
        grid = cus;
    }
    if (grid < 0) return;
    Params p{};
    for (int i = 0; i < 14; ++i) p.in[i] = (const float*)d_in[i];
    p.out = (float*)d_out; p.ws = (unsigned char*)d_ws;
#if MULTI_LAUNCH
    for (int k = 0; k < N_PHASES; ++k) { p.ph_lo = k; p.ph_hi = k + 1; hipLaunchKernelGGL(mega, dim3(grid), dim3(512), LDS_BYTES, stream, p); }
#else
    p.ph_lo = 0; p.ph_hi = N_PHASES;
    void* args[] = {&p};
    hipError_t e = hipLaunchCooperativeKernel((const void*)mega, dim3(grid), dim3(512), args, LDS_BYTES, stream);
    if (e != hipSuccess) fprintf(stderr, "cooperative launch failed: %s (grid %d)\n", hipGetErrorString(e), grid);
#endif
}
```

```cpp
#include <hip/hip_runtime.h>
#include <hip/hip_cooperative_groups.h>
#include <cstdio>
namespace cg = cooperative_groups;

#ifndef MULTI_LAUNCH
#define MULTI_LAUNCH 0
#endif
#ifndef PROBE_NDUP
#define PROBE_NDUP 0
#define PROBE_DUPS 0
#endif

#define LAS __attribute__((address_space(3)))
typedef unsigned short bf16_t;
typedef short bf16x8 __attribute__((ext_vector_type(8)));
typedef float f32x4 __attribute__((ext_vector_type(4)));
typedef float f32x2 __attribute__((ext_vector_type(2)));
typedef unsigned u32x4 __attribute__((ext_vector_type(4)));
typedef unsigned u32x2 __attribute__((ext_vector_type(2)));

constexpr int NTOK = 32768, SEQ = 4096, DM = 1024, DFF = 2816, HTOK = 16384;
constexpr int BM = 256, BK = 64, HALF = 128, HTB = HALF * BK * 2, STAGE_BYTES = 8 * HTB, NXCD = 8, WGM = 8;
constexpr int MODW = 26624;
constexpr int LDS_BYTES = STAGE_BYTES + 1024;
constexpr size_t MiB = 1048576;
constexpr size_t WS_MOD = 0, WS_ROPE = 1 * MiB, WS_ROPET = 5 * MiB, WS_CS = 9 * MiB, WS_STATS = 10 * MiB;
constexpr size_t WS_BAR = 900 * 1024;
constexpr size_t WS_W = 14 * MiB;
constexpr size_t W_MIXIN = WS_W, W_MIXOUT = WS_W + 12 * MiB, W_FFNIN = WS_W + 16 * MiB, W_FFNOUT = WS_W + 27 * MiB;
constexpr size_t WS_H = 47 * MiB;
constexpr size_t WS_BIG = 111 * MiB;
constexpr size_t WS_Y1 = WS_BIG, WS_Y2 = WS_BIG + 128 * MiB, WS_FO = WS_BIG + 256 * MiB;
constexpr size_t WS_TA = WS_CS + 256 * 1024, WS_TB = WS_TA + 64 * 1024;
constexpr size_t WS_A2 = WS_BIG, WS_B2 = WS_BIG + 128 * MiB, WS_KTM = WS_BIG + 256 * MiB, WS_KFT = WS_BIG + 288 * MiB, WS_KBT = WS_BIG + 320 * MiB;
constexpr size_t WS_Y = WS_KTM;
constexpr size_t WS_HID = WS_BIG, WS_MODP = WS_BIG;
constexpr size_t WS_END = WS_BIG + 352 * MiB;

__device__ __forceinline__ int lds_byte(int r, int c) { const int st = (r >> 4) * 2 + (c >> 5), rr = r & 15, cc = c & 31, ob = rr * 64 + cc * 2; return st * 1024 + (ob ^ (((ob >> 9) & 1) << 5)); }
__device__ __forceinline__ void stage_rc(int b, int& R, int& C) { const int st = b / 1024, sb = b % 1024, swz = sb ^ (((sb >> 9) & 1) << 5); R = (st >> 1) * 16 + swz / 64; C = (st & 1) * 32 + (swz % 64) / 2; }
__device__ __forceinline__ int perm32(int rho) { const int n = rho >> 4, i = rho & 15; return 8 * (i >> 2) + 4 * n + (i & 3); }
__device__ __forceinline__ unsigned cvt_pk_bf16(float lo, float hi) { unsigned r; asm volatile("v_cvt_pk_bf16_f32 %0, %1, %2" : "=v"(r) : "v"(lo), "v"(hi)); return r; }
__device__ __forceinline__ u32x4 pack8(const f32x4 a, const f32x4 b) { u32x4 w; w.x = cvt_pk_bf16(a[0], a[1]); w.y = cvt_pk_bf16(a[2], a[3]); w.z = cvt_pk_bf16(b[0], b[1]); w.w = cvt_pk_bf16(b[2], b[3]); return w; }
__device__ __forceinline__ float bf_lo(unsigned w) { return __uint_as_float(w << 16); }
__device__ __forceinline__ float bf_hi(unsigned w) { return __uint_as_float(w & 0xffff0000u); }
__device__ __forceinline__ float siluf(float v) { return v * __builtin_amdgcn_rcpf(1.0f + __expf(-v)); }
__device__ __forceinline__ float lg2gamma(int h) { return log2f(1.0f - exp2f(-5.0f - (float)h)); }

struct Unit { unsigned ao, bo; int pm, pn, z; };

struct Order {
    int nM, nN, total, G, c;
    __device__ __forceinline__ void init(int nM_, int nN_, int nz, int G_, int c_) { nM = nM_; nN = nN_; total = nM_ * nN_ * nz; G = G_; c = c_; }
    __device__ __forceinline__ bool get(int i, int& z, int& pm, int& pn) const {
        const int L = i * G + c; if (L >= total) return false;
        int wgid = L; { const int q = total / NXCD, r = total % NXCD, xcd = wgid % NXCD, off = wgid / NXCD; wgid = (xcd < r ? xcd * (q + 1) : r * (q + 1) + (xcd - r) * q) + off; }
        const int per = nM * nN; z = wgid / per; const int w = wgid % per;
        const int nig = WGM * nN, gid = w / nig, fm = gid * WGM, gsz = (nM - fm) < WGM ? (nM - fm) : WGM;
        pm = fm + ((w % nig) % gsz); pn = (w % nig) / gsz; return true;
    }
};
struct GSched {
    Order o; const char* A; const char* B; int n1, n0; unsigned a2, a1, a0, apm, b2, b1, b0, bpn;
    __device__ __forceinline__ const char* baseA() const { return A; }
    __device__ __forceinline__ const char* baseB() const { return B; }
    __device__ __forceinline__ bool next(int i, Unit& u) const {
        int z, pm, pn; if (!o.get(i, z, pm, pn)) return false;
        const int z0 = z % n0, z1 = (z / n0) % n1, z2 = z / (n0 * n1);
        u.z = z; u.pm = pm; u.pn = pn;
        u.ao = z2 * a2 + z1 * a1 + z0 * a0 + pm * apm; u.bo = z2 * b2 + z1 * b1 + z0 * b0 + pn * bpn; return true;
    }
};

template <class Epi, class Sched>
__device__ __forceinline__ void gemm_phase(const int tid, LAS unsigned char* lds, const Sched& S, const Epi& E, const int lda_, const int ldb_, const int nt_) {
    int lda = lda_, ldb = ldb_, nt = nt_; asm volatile("" : "+s"(lda), "+s"(ldb), "+s"(nt));
    const int wid = __builtin_amdgcn_readfirstlane(tid >> 6), lane = tid & 63, wr = wid >> 2, wc = wid & 3, fr = lane & 15, fq = lane >> 4;
    unsigned voffA[2], voffB[2];
#pragma unroll
    for (int i = 0; i < 2; ++i) { int R, C; stage_rc(tid * 16 + i * 8192, R, C); const int Rb = Epi::PERM ? ((R & ~31) + perm32(R & 31)) : R;
        const int Rt = Epi::BMAP ? (64 * (Rb & 63) + (Rb >> 6)) : Rb;
        voffA[i] = (unsigned)(R * lda + C) * 2u; voffB[i] = (unsigned)(Rt * ldb + C) * 2u; }
    const size_t kstep = (size_t)(BK * 2);
    const size_t hstepA = (size_t)HALF * lda * 2, hstepB = (size_t)(Epi::BMAP ? 2 : HALF) * ldb * 2;
    const unsigned ldsw = (unsigned)wid * 1024u;
    const int aoff = lds_byte(wr * 64 + fr, fq * 8), boff = lds_byte(wc * 32 + fr, fq * 8);
#define PG8_SA(b, h) (((b) * 2 + (h)) * HTB)
#define PG8_SB(b, h) ((4 + (b) * 2 + (h)) * HTB)
#define PG8_STAGE(bufoff, gbase, voff) do { _Pragma("unroll") for (int _i = 0; _i < 2; ++_i) \
        __builtin_amdgcn_global_load_lds((const unsigned*)((const char*)(gbase) + (voff)[_i]), (LAS unsigned*)(lds + (bufoff) + ldsw + _i * 8192), 16, 0, 0); } while (0)
#define PG8_LDA(dst, b, h) do { _Pragma("unroll") for (int m = 0; m < 4; ++m) _Pragma("unroll") for (int k = 0; k < 2; ++k) dst[m][k] = *(const LAS bf16x8*)(lds + PG8_SA(b, h) + aoff + m * 2048 + k * 1024); } while (0)
#define PG8_LDB(dst, b, h) do { _Pragma("unroll") for (int n = 0; n < 2; ++n) _Pragma("unroll") for (int k = 0; k < 2; ++k) dst[n][k] = *(const LAS bf16x8*)(lds + PG8_SB(b, h) + boff + n * 2048 + k * 1024); } while (0)
#define PG8_MMA(ai, bj, At, Bt) do { __builtin_amdgcn_s_setprio(1); _Pragma("unroll") for (int m = 0; m < 4; ++m) _Pragma("unroll") for (int n = 0; n < 2; ++n) _Pragma("unroll") for (int k = 0; k < 2; ++k) \
        acc[ai][bj][m][n] = __builtin_amdgcn_mfma_f32_16x16x32_bf16(Bt[n][k], At[m][k], acc[ai][bj][m][n], 0, 0, 0); __builtin_amdgcn_s_setprio(0); } while (0)
#define PG8_WAIT_V(n) asm volatile("s_waitcnt vmcnt(" #n ")" ::: "memory")
#define PG8_WAIT_L(n) asm volatile("s_waitcnt lgkmcnt(" #n ")" ::: "memory")
#define PG8_BAR __builtin_amdgcn_s_barrier()
#define PG8_SCHED __builtin_amdgcn_sched_barrier(0)
    LAS int* ul = (LAS int*)(lds + STAGE_BYTES);
    if (tid < 16) { Unit u; u.ao = 0; u.bo = 0; u.pm = 0; u.pn = 0; u.z = 0; const bool ok = S.next(tid, u);
        ul[tid * 8 + 0] = ok ? 1 : 0; ul[tid * 8 + 1] = (int)u.ao; ul[tid * 8 + 2] = (int)u.bo; ul[tid * 8 + 3] = u.pm; ul[tid * 8 + 4] = u.pn; ul[tid * 8 + 5] = u.z; }
    __syncthreads();
#define PG8_UNIT(i, u, ok) do { const int _i = (i); ok = _i < 16 && __builtin_amdgcn_readfirstlane(ul[(_i & 15) * 8]) != 0; \
        u.ao = (unsigned)__builtin_amdgcn_readfirstlane(ul[(_i & 15) * 8 + 1]); u.bo = (unsigned)__builtin_amdgcn_readfirstlane(ul[(_i & 15) * 8 + 2]); \
        u.pm = __builtin_amdgcn_readfirstlane(ul[(_i & 15) * 8 + 3]); u.pn = __builtin_amdgcn_readfirstlane(ul[(_i & 15) * 8 + 4]); u.z = __builtin_amdgcn_readfirstlane(ul[(_i & 15) * 8 + 5]); } while (0)
    const char* const Abase = S.baseA(); const char* const Bbase = S.baseB();
    Unit cur, nxt; int ui = 0;
    { bool ok0; PG8_UNIT(0, cur, ok0); if (!ok0) return; }
    f32x4 acc[2][2][4][2];
#pragma unroll
    for (int a = 0; a < 2; ++a)
#pragma unroll
        for (int b = 0; b < 2; ++b)
#pragma unroll
            for (int m = 0; m < 4; ++m)
#pragma unroll
                for (int n = 0; n < 2; ++n) acc[a][b][m][n] = (f32x4){0.f, 0.f, 0.f, 0.f};
    bf16x8 At[4][2], B0[2][2], B1[2][2];
    const char* cA = Abase + ((size_t)cur.ao << 8); const char* cB = Bbase + ((size_t)cur.bo << 8);
    PG8_STAGE(PG8_SB(0, 0), cB, voffB); PG8_STAGE(PG8_SA(0, 0), cA, voffA); PG8_STAGE(PG8_SB(0, 1), cB + hstepB, voffB); PG8_STAGE(PG8_SA(0, 1), cA + hstepA, voffA);
    if (wr == 1) PG8_BAR;
    PG8_WAIT_V(4); PG8_BAR;
    PG8_STAGE(PG8_SB(1, 0), cB + kstep, voffB); PG8_STAGE(PG8_SA(1, 0), cA + kstep, voffA); PG8_STAGE(PG8_SB(1, 1), cB + hstepB + kstep, voffB);
    PG8_WAIT_V(6); PG8_BAR;
    for (;;) {
        bool has_next; PG8_UNIT(ui + 1, nxt, has_next);
        const char* nA = has_next ? Abase + ((size_t)nxt.ao << 8) : cA; const char* nB = has_next ? Bbase + ((size_t)nxt.bo << 8) : cB;
        for (int t = 0; t < nt; t += 2) {
            const bool last = (t == nt - 2);
            const char* a1 = cA + (size_t)(t + 1) * kstep;
            const char* a2 = last ? nA : cA + (size_t)(t + 2) * kstep; const char* b2 = last ? nB : cB + (size_t)(t + 2) * kstep;
            const char* a3 = a2 + kstep; const char* b3 = b2 + kstep;
            PG8_LDB(B0, 0, 0); PG8_SCHED; PG8_LDA(At, 0, 0); PG8_STAGE(PG8_SA(1, 1), a1 + hstepA, voffA);
            PG8_WAIT_L(8); PG8_BAR; PG8_WAIT_L(0); PG8_MMA(0, 0, At, B0); PG8_BAR; PG8_SCHED;
            PG8_LDB(B1, 0, 1); PG8_STAGE(PG8_SB(0, 0), b2, voffB);
            PG8_BAR; PG8_WAIT_L(0); PG8_MMA(0, 1, At, B1); PG8_BAR;
            PG8_LDA(At, 0, 1); PG8_STAGE(PG8_SA(0, 0), a2, voffA);
            PG8_BAR; PG8_WAIT_L(0); PG8_MMA(1, 0, At, B0); PG8_BAR; PG8_SCHED;
            PG8_STAGE(PG8_SB(0, 1), b2 + hstepB, voffB);
            PG8_WAIT_V(6); PG8_BAR; PG8_MMA(1, 1, At, B1); PG8_BAR;
            PG8_LDB(B0, 1, 0); PG8_SCHED; PG8_LDA(At, 1, 0); PG8_STAGE(PG8_SA(0, 1), a2 + hstepA, voffA);
            PG8_WAIT_L(8); PG8_BAR; PG8_WAIT_L(0); PG8_MMA(0, 0, At, B0); PG8_BAR; PG8_SCHED;
            PG8_LDB(B1, 1, 1); PG8_STAGE(PG8_SB(1, 0), b3, voffB);
            PG8_BAR; PG8_WAIT_L(0); PG8_MMA(0, 1, At, B1); PG8_BAR;
            PG8_LDA(At, 1, 1); PG8_STAGE(PG8_SA(1, 0), a3, voffA);
            PG8_BAR; PG8_WAIT_L(0); PG8_MMA(1, 0, At, B0); PG8_BAR; PG8_SCHED;
            PG8_STAGE(PG8_SB(1, 1), b3 + hstepB, voffB);
            PG8_WAIT_V(6); PG8_BAR; PG8_MMA(1, 1, At, B1); PG8_BAR;
        }
        E(acc, cur, wr, wc, fr, fq);
        if (!has_next) break;
        if constexpr (!Epi::KEEP_ACC) {
#pragma unroll
            for (int a = 0; a < 2; ++a)
#pragma unroll
                for (int b = 0; b < 2; ++b)
#pragma unroll
                    for (int m = 0; m < 4; ++m)
#pragma unroll
                        for (int n = 0; n < 2; ++n) acc[a][b][m][n] = (f32x4){0.f, 0.f, 0.f, 0.f};
        }
        cur = nxt; cA = nA; cB = nB; ++ui;
    }
    PG8_WAIT_V(0);
    if (wr == 0) PG8_BAR;
    PG8_BAR;
#undef PG8_UNIT
#undef PG8_SA
#undef PG8_SB
#undef PG8_STAGE
#undef PG8_LDA
#undef PG8_LDB
#undef PG8_MMA
#undef PG8_WAIT_V
#undef PG8_WAIT_L
#undef PG8_BAR
#undef PG8_SCHED
}

typedef f32x4 Acc[2][2][4][2];

struct EpiResid {
    static constexpr bool PERM = true, KEEP_ACC = false, BMAP = false;
    const float* base32; const bf16_t* base16; bf16_t* out; const float* gate  ; int row0;
    __device__ __forceinline__ void operator()(Acc& acc, const Unit& u, int wr, int wc, int fr, int fq) const {
        const int rowt = row0 + u.pm * BM, b = rowt / SEQ; const int col0 = u.pn * BM + wc * 32 + 8 * fq;
        f32x4 gv[2][2];
#pragma unroll
        for (int bj = 0; bj < 2; ++bj)
#pragma unroll
            for (int n = 0; n < 2; ++n) gv[bj][n] = *(const f32x4*)(gate + (size_t)b * MODW + col0 + bj * HALF + 4 * n);
        if (base32) {
#pragma unroll
            for (int ai = 0; ai < 2; ++ai)
#pragma unroll
                for (int m = 0; m < 4; ++m) { const size_t off = (size_t)(rowt + ai * HALF + wr * 64 + m * 16 + fr) * DM + col0;
#pragma unroll
                    for (int bj = 0; bj < 2; ++bj) { const f32x4 b0 = *(const f32x4*)(base32 + off + bj * HALF), b1 = *(const f32x4*)(base32 + off + bj * HALF + 4);
                        *(u32x4*)(out + off + bj * HALF) = pack8(b0 + gv[bj][0] * acc[ai][bj][m][0], b1 + gv[bj][1] * acc[ai][bj][m][1]); }
                    asm volatile("" ::: "memory"); }
        } else {
#pragma unroll
            for (int ai = 0; ai < 2; ++ai)
#pragma unroll
                for (int m = 0; m < 4; ++m) { const size_t off = (size_t)(rowt + ai * HALF + wr * 64 + m * 16 + fr) * DM + col0;
#pragma unroll
                    for (int bj = 0; bj < 2; ++bj) { const u32x4 w = *(const u32x4*)(base16 + off + bj * HALF);
                        const f32x4 b0 = {bf_lo(w.x), bf_hi(w.x), bf_lo(w.y), bf_hi(w.y)}, b1 = {bf_lo(w.z), bf_hi(w.z), bf_lo(w.w), bf_hi(w.w)};
                        *(u32x4*)(out + off + bj * HALF) = pack8(b0 + gv[bj][0] * acc[ai][bj][m][0], b1 + gv[bj][1] * acc[ai][bj][m][1]); }
                    asm volatile("" ::: "memory"); }
        }
    }
};
struct EpiBf16 {
    static constexpr bool PERM = true, KEEP_ACC = false, BMAP = false;
    bf16_t* O; int ldo; int zrows;
    __device__ __forceinline__ void operator()(Acc& acc, const Unit& u, int wr, int wc, int fr, int fq) const {
        const int row0 = u.z * zrows + u.pm * BM + wr * 64 + fr, col0 = u.pn * BM + wc * 32 + 8 * fq;
#pragma unroll
        for (int ai = 0; ai < 2; ++ai)
#pragma unroll
            for (int m = 0; m < 4; ++m) { bf16_t* rowp = O + (size_t)(row0 + ai * HALF + m * 16) * ldo + col0;
#pragma unroll
                for (int bj = 0; bj < 2; ++bj) *(u32x4*)(rowp + bj * HALF) = pack8(acc[ai][bj][m][0], acc[ai][bj][m][1]); }
    }
};
struct EpiChanDft {
    static constexpr bool PERM = true, KEEP_ACC = false, BMAP = true;
    bf16_t* Y1;
    __device__ __forceinline__ void operator()(Acc& acc, const Unit& u, int wr, int wc, int fr, int fq) const {
        const int b = u.z & 7, g = u.z >> 3;
#pragma unroll
        for (int ai = 0; ai < 2; ++ai)
#pragma unroll
            for (int m = 0; m < 4; ++m) { const int j = ai * HALF + wr * 64 + m * 16 + fr;
#pragma unroll
                for (int bj = 0; bj < 2; ++bj) { const int s2 = 4 * u.pn + 2 * bj + (wc >> 1), s1 = 32 * (wc & 1) + 8 * fq;
                    *(u32x4*)(Y1 + ((((size_t)(b * DM + g * 256 + j) * 64 + s2) * 2 + u.pm) * 64 + s1)) = pack8(acc[ai][bj][m][0], acc[ai][bj][m][1]); } }
    }
};
struct EpiFftA {
    static constexpr bool PERM = true, KEEP_ACC = false, BMAP = false;
    bf16_t* Y2;
    __device__ __forceinline__ void operator()(Acc& acc, const Unit& u, int wr, int wc, int fr, int fq) const {
        const int b = u.pn >> 8;
#pragma unroll
        for (int mm = 0; mm < 2; ++mm) { const int k1 = 32 * wr + 16 * mm + fr;
#pragma unroll
            for (int bj = 0; bj < 2; ++bj) { const int c = ((u.pn * 4) & 1023) + 2 * bj + (wc >> 1), s20 = 32 * (wc & 1) + 8 * fq; f32x4 yr[2], yi[2];
#pragma unroll
                for (int n = 0; n < 2; ++n)
#pragma unroll
                    for (int e = 0; e < 4; ++e) { const float th = (float)(k1 * (s20 + 4 * n + e)) * (1.0f / 4096.0f); const float cs = __builtin_amdgcn_cosf(th), sn = __builtin_amdgcn_sinf(th);
                        const float re = acc[0][bj][2 * mm][n][e], im = acc[0][bj][2 * mm + 1][n][e]; yr[n][e] = re * cs + im * sn; yi[n][e] = im * cs - re * sn; }
                bf16_t* dst = Y2 + ((((size_t)(b * 64 + k1) * DM + c) * 2) * 64 + s20);
                *(u32x4*)(dst) = pack8(yr[0], yr[1]); *(u32x4*)(dst + 64) = pack8(yi[0], yi[1]); } }
    }
};
struct EpiFftB {
    static constexpr bool PERM = true, KEEP_ACC = false, BMAP = false;
    bf16_t* FO;
    __device__ __forceinline__ void operator()(Acc& acc, const Unit& u, int wr, int wc, int fr, int fq) const {
        if (wr != 0) return;
        const int bk = u.pn >> 2, b = bk >> 6, k1 = bk & 63, c0 = (u.pn & 3) * 256 + wc * 32 + 8 * fq;
#pragma unroll
        for (int m = 0; m < 4; ++m) { const int k2 = 16 * m + fr; bf16_t* rowp = FO + (size_t)(b * SEQ + k1 + 64 * k2) * DM + c0;
#pragma unroll
            for (int bj = 0; bj < 2; ++bj) *(u32x4*)(rowp + bj * HALF) = pack8(acc[0][bj][m][0], acc[0][bj][m][1]); }
    }
};
struct EpiSwiglu {
    static constexpr bool PERM = true, KEEP_ACC = false, BMAP = false;
    bf16_t* O;
    __device__ __forceinline__ void operator()(Acc& acc, const Unit& u, int wr, int wc, int fr, int fq) const {
        const int row0 = u.pm * BM + wr * 64 + fr, col0 = u.pn * HALF + wc * 32 + 8 * fq;
#pragma unroll
        for (int ai = 0; ai < 2; ++ai)
#pragma unroll
            for (int m = 0; m < 4; ++m) { f32x4 v0, v1;
#pragma unroll
                for (int e = 0; e < 4; ++e) { v0[e] = siluf(acc[ai][0][m][0][e]) * acc[ai][1][m][0][e]; v1[e] = siluf(acc[ai][0][m][1][e]) * acc[ai][1][m][1][e]; }
                *(u32x4*)(O + (size_t)(row0 + ai * HALF + m * 16) * DFF + col0) = pack8(v0, v1); }
    }
};
struct EpiQK {
    static constexpr bool PERM = true, KEEP_ACC = false, BMAP = false;
    bf16_t* A2; bf16_t* KTM; const float* rope  ;
    __device__ __forceinline__ void operator()(Acc& acc, const Unit& u, int wr, int wc, int fr, int fq) const {
        const bool isq = u.pn < 4; const int h = isq ? u.pn : u.pn - 4; const int i0 = wc * 32 + 8 * fq;
        const float lgf = lg2gamma(h), lgb = lg2gamma(3 - h);
#pragma unroll
        for (int ai = 0; ai < 2; ++ai)
#pragma unroll
            for (int m = 0; m < 4; ++m) {
                const int tl = u.pm * BM + ai * HALF + wr * 64 + m * 16 + fr, s = tl % SEQ, sl = s % 512;
                const f32x4* rp = (const f32x4*)(rope + ((size_t)s * 128 + i0) * 2);
                f32x4 o1[2], o2[2];
#pragma unroll
                for (int n = 0; n < 2; ++n) { const f32x4 r0 = rp[2 * n], r1 = rp[2 * n + 1]; const f32x4 x1 = acc[ai][0][m][n], x2 = acc[ai][1][m][n];
                    const float cs[4] = {r0[0], r0[2], r1[0], r1[2]}, sn[4] = {r0[1], r0[3], r1[1], r1[3]};
#pragma unroll
                    for (int e = 0; e < 4; ++e) { o1[n][e] = x1[e] * cs[e] - x2[e] * sn[e]; o2[n][e] = x1[e] * sn[e] + x2[e] * cs[e]; } }
                if (isq) {
                    const float df = exp2f((float)(sl + 1) * lgf), db = exp2f((float)(512 - sl) * lgb);
                    bf16_t* rowp = A2 + ((size_t)tl * 4 + h) * 1024 + 512 + i0;
                    *(u32x4*)(rowp) = pack8(o1[0] * df, o1[1] * df); *(u32x4*)(rowp + 128) = pack8(o2[0] * df, o2[1] * df);
                    *(u32x4*)(rowp + 256) = pack8(o1[0] * db, o1[1] * db); *(u32x4*)(rowp + 384) = pack8(o2[0] * db, o2[1] * db);
                } else {
                    bf16_t* rowp = KTM + (size_t)tl * 1024 + h * 256 + i0;
                    *(u32x4*)(rowp) = pack8(o1[0] * 0.0625f, o1[1] * 0.0625f); *(u32x4*)(rowp + 128) = pack8(o2[0] * 0.0625f, o2[1] * 0.0625f);
                }
            }
    }
};
struct EpiKVT {
    static constexpr bool PERM = true, KEEP_ACC = false, BMAP = false;
    bf16_t* KFT; bf16_t* KBT; bf16_t* B2; const float* ropet  ;
    __device__ __forceinline__ void operator()(Acc& acc, const Unit& u, int wr, int wc, int fr, int fq) const {
        if (u.pm < 4) {
            const int h = u.pm; const float lgf = lg2gamma(h), lgb = lg2gamma(3 - h);
#pragma unroll
            for (int bj = 0; bj < 2; ++bj) {
                const int tl0 = u.pn * BM + bj * HALF + wc * 32 + 8 * fq, b = tl0 / SEQ, s0 = tl0 % SEQ, sl0 = s0 % 512;
                f32x4 kfd[2], kbd[2];
#pragma unroll
                for (int n = 0; n < 2; ++n)
#pragma unroll
                    for (int e = 0; e < 4; ++e) { const int sl = sl0 + 4 * n + e; kfd[n][e] = 0.0625f * exp2f((float)(511 - sl) * lgf); kbd[n][e] = 0.0625f * exp2f((float)sl * lgb); }
#pragma unroll
                for (int m = 0; m < 4; ++m) {
                    const int i = wr * 64 + m * 16 + fr;
                    const f32x4* rp = (const f32x4*)(ropet + ((size_t)i * SEQ + s0) * 2);
                    f32x4 o1[2], o2[2];
#pragma unroll
                    for (int n = 0; n < 2; ++n) { const f32x4 r0 = rp[2 * n], r1 = rp[2 * n + 1]; const f32x4 x1 = acc[0][bj][m][n], x2 = acc[1][bj][m][n];
                        const float cs[4] = {r0[0], r0[2], r1[0], r1[2]}, sn[4] = {r0[1], r0[3], r1[1], r1[3]};
#pragma unroll
                        for (int e = 0; e < 4; ++e) { o1[n][e] = x1[e] * cs[e] - x2[e] * sn[e]; o2[n][e] = x1[e] * sn[e] + x2[e] * cs[e]; } }
                    const size_t r1off = ((size_t)(b * 4 + h) * 256 + i) * SEQ + s0, r2off = r1off + (size_t)128 * SEQ;
                    *(u32x4*)(KFT + r1off) = pack8(o1[0] * kfd[0], o1[1] * kfd[1]); *(u32x4*)(KFT + r2off) = pack8(o2[0] * kfd[0], o2[1] * kfd[1]);
                    *(u32x4*)(KBT + r1off) = pack8(o1[0] * kbd[0], o1[1] * kbd[1]); *(u32x4*)(KBT + r2off) = pack8(o2[0] * kbd[0], o2[1] * kbd[1]);
                }
            }
        } else {
            const int h = (u.pm - 4) >> 1, dv0 = ((u.pm - 4) & 1) * 256;
#pragma unroll
            for (int bj = 0; bj < 2; ++bj) {
                const int tl0 = u.pn * BM + bj * HALF + wc * 32 + 8 * fq, b = tl0 / SEQ, s0 = tl0 % SEQ, np = s0 / 512, sl0 = s0 % 512;
#pragma unroll
                for (int ai = 0; ai < 2; ++ai)
#pragma unroll
                    for (int m = 0; m < 4; ++m) { const int dv = dv0 + ai * HALF + wr * 64 + m * 16 + fr;
                        *(u32x4*)(B2 + (((size_t)((b * 4 + h) * 8 + np) * 512 + dv) * 1024 + sl0)) = pack8(acc[ai][bj][m][0], acc[ai][bj][m][1]); }
            }
        }
    }
};
struct EpiScores {
    static constexpr bool PERM = true, KEEP_ACC = false, BMAP = false;
    bf16_t* A2;
    __device__ __forceinline__ void operator()(Acc& acc, const Unit& u, int wr, int wc, int fr, int fq) const {
        const int np = u.z % 8, h = (u.z / 8) % 4, b = u.z / 32; const float lgf = lg2gamma(h), lgb = lg2gamma(3 - h);
#pragma unroll
        for (int bj = 0; bj < 2; ++bj) { const int s0 = u.pn * BM + bj * HALF + wc * 32 + 8 * fq; float c1[8], c2[8];
#pragma unroll
            for (int e = 0; e < 8; ++e) { c1[e] = exp2f(-(float)(s0 + e + 1) * lgf); c2[e] = exp2f((float)(s0 + e) * lgb); }
#pragma unroll
            for (int ai = 0; ai < 2; ++ai)
#pragma unroll
                for (int m = 0; m < 4; ++m) { const int t = u.pm * BM + ai * HALF + wr * 64 + m * 16 + fr; const float rt = exp2f(-(float)t * lgb - (float)(t + 1) * lgf);
                    f32x4 v[2];
#pragma unroll
                    for (int n = 0; n < 2; ++n)
#pragma unroll
                        for (int e = 0; e < 4; ++e) { const int s = s0 + 4 * n + e; v[n][e] = acc[ai][bj][m][n][e] * ((s <= t) ? c1[4 * n + e] : c2[4 * n + e] * rt); }
                    *(u32x4*)(A2 + ((size_t)(b * SEQ + np * 512 + t) * 4 + h) * 1024 + s0) = pack8(v[0], v[1]); } }
    }
};
struct EpiState {
    static constexpr bool PERM = true, KEEP_ACC = false, BMAP = false;
    bf16_t* B2;
    __device__ __forceinline__ void operator()(Acc& acc, const Unit& u, int wr, int wc, int fr, int fq) const {
        const int dvh = u.z & 1, slot = (u.z >> 1) & 7, dir = (u.z >> 4) & 1, bh = u.z >> 5;
        const int col0 = 512 + dir * 256 + wc * 32 + 8 * fq;
#pragma unroll
        for (int ai = 0; ai < 2; ++ai)
#pragma unroll
            for (int m = 0; m < 4; ++m) { const int dv = dvh * 256 + ai * HALF + wr * 64 + m * 16 + fr;
                bf16_t* rowp = B2 + ((size_t)(bh * 8 + slot) * 512 + dv) * 1024 + col0;
#pragma unroll
                for (int bj = 0; bj < 2; ++bj) *(u32x4*)(rowp + bj * HALF) = pack8(acc[ai][bj][m][0], acc[ai][bj][m][1]); }
    }
};
struct StateSched {
    const char* B2; const char* KFT; int G, c;
    __device__ __forceinline__ const char* baseA() const { return B2; }
    __device__ __forceinline__ const char* baseB() const { return KFT; }
    __device__ __forceinline__ bool next(int i, Unit& u) const {
        const int L = i * G + c; if (L >= 448) return false;
        const int wgid = (L % NXCD) * 56 + L / NXCD;
        const int bh = wgid / 28, r = wgid % 28; int ci, dir, dvh;
        if (r < 2) { ci = 0; dir = 0; dvh = r; } else if (r < 26) { const int r2 = r - 2; ci = 1 + (r2 >> 2); dir = (r2 >> 1) & 1; dvh = r2 & 1; } else { ci = 7; dir = 1; dvh = r - 26; }
        const int slot = dir ? ci - 1 : ci + 1;
        u.pm = 0; u.pn = 0; u.z = ((bh * 2 + dir) * 8 + slot) * 2 + dvh;
        u.ao = (unsigned)(((bh * 8 + ci) * 512 + dvh * 256) * 8);
        u.bo = (unsigned)(dir * 131072 + bh * 256 * 32 + ci * 4);
        return true;
    }
};
struct EpiRetOut {
    static constexpr bool PERM = true, KEEP_ACC = false, BMAP = false;
    bf16_t* Y; float* stats;
    __device__ __forceinline__ void operator()(Acc& acc, const Unit& u, int wr, int wc, int fr, int fq) const {
        const int np = u.z % 8, h = (u.z / 8) % 4, b = u.z / 32;
#pragma unroll
        for (int ai = 0; ai < 2; ++ai)
#pragma unroll
            for (int m = 0; m < 4; ++m) { const int tl = b * SEQ + np * 512 + u.pm * BM + ai * HALF + wr * 64 + m * 16 + fr;
                float s = 0.f, q = 0.f;
#pragma unroll
                for (int bj = 0; bj < 2; ++bj)
#pragma unroll
                    for (int n = 0; n < 2; ++n) { const f32x4 x = acc[ai][bj][m][n]; s += (x[0] + x[1]) + (x[2] + x[3]); q += (x[0] * x[0] + x[1] * x[1]) + (x[2] * x[2] + x[3] * x[3]); }
                s += __shfl_xor(s, 16); s += __shfl_xor(s, 32); q += __shfl_xor(q, 16); q += __shfl_xor(q, 32);
                if (fq == 0) *(f32x2*)(stats + (((size_t)tl * 4 + h) * 8 + u.pn * 4 + wc) * 2) = (f32x2){s, q};
                bf16_t* rowp = Y + (size_t)tl * 2048 + h * 512 + u.pn * BM + wc * 32 + 8 * fq;
#pragma unroll
                for (int bj = 0; bj < 2; ++bj) *(u32x4*)(rowp + bj * HALF) = pack8(acc[ai][bj][m][0], acc[ai][bj][m][1]); }
    }
};
struct EpiGate {
    static constexpr bool PERM = true, KEEP_ACC = false, BMAP = false;
    bf16_t* Y; const float* stats;
    __device__ __forceinline__ void operator()(Acc& acc, const Unit& u, int wr, int wc, int fr, int fq) const {
        const int h = u.pn >> 1;
#pragma unroll
        for (int ai = 0; ai < 2; ++ai)
#pragma unroll
            for (int m = 0; m < 4; ++m) { const int tl = u.pm * BM + ai * HALF + wr * 64 + m * 16 + fr;
                const f32x4* sp = (const f32x4*)(stats + ((size_t)tl * 4 + h) * 16); float s = 0.f, q = 0.f;
#pragma unroll
                for (int k = 0; k < 4; ++k) { const f32x4 v = sp[k]; s += v[0] + v[2]; q += v[1] + v[3]; }
                const float mu = s * (1.0f / 512.0f), var = fmaxf(q * (1.0f / 512.0f) - mu * mu, 0.f), rstd = rsqrtf(var + 1e-6f);
                bf16_t* rowp = Y + (size_t)tl * 2048 + u.pn * BM + wc * 32 + 8 * fq;
#pragma unroll
                for (int bj = 0; bj < 2; ++bj) { const u32x4 yw = *(const u32x4*)(rowp + bj * HALF);
                    const float yv[8] = {bf_lo(yw.x), bf_hi(yw.x), bf_lo(yw.y), bf_hi(yw.y), bf_lo(yw.z), bf_hi(yw.z), bf_lo(yw.w), bf_hi(yw.w)};
                    f32x4 v0, v1;
#pragma unroll
                    for (int e = 0; e < 4; ++e) { v0[e] = siluf(acc[ai][bj][m][0][e]) * (yv[e] - mu) * rstd; v1[e] = siluf(acc[ai][bj][m][1][e]) * (yv[4 + e] - mu) * rstd; }
                    *(u32x4*)(rowp + bj * HALF) = pack8(v0, v1); }
                asm volatile("" ::: "memory"); }
    }
};

template <int MODE>
__device__ __forceinline__ void conv_weight(const int tid, const float* W, int K, int N, bf16_t* WT, int bx, int G) {
    const int nitems = (K >> 3) * N;
#pragma unroll 2
    for (int idx = bx * 512 + tid; idx < nitems; idx += G * 512) {
        const int n = idx % N, k0 = (idx / N) * 8; float v[8];
#pragma unroll
        for (int e = 0; e < 8; ++e) v[e] = W[(size_t)(k0 + e) * N + n];
        int nn = n;
        if (MODE == 1) { const int j = nn < DFF ? nn : nn - DFF; nn = 256 * (j >> 7) + (nn < DFF ? 0 : 128) + (j & 127); }
        u32x4 w; w.x = cvt_pk_bf16(v[0], v[1]); w.y = cvt_pk_bf16(v[2], v[3]); w.z = cvt_pk_bf16(v[4], v[5]); w.w = cvt_pk_bf16(v[6], v[7]);
        *(u32x4*)(WT + (size_t)nn * K + k0) = w;
    }
}
template <bool IN16, bool FINAL>
__device__ __forceinline__ void norm_rows(const int tid, const int bx, const int G, const float* x32, const bf16_t* x16, const float* g, const float* mod, int shoff, int scoff, bf16_t* h, float* outf) {
    const int lane = tid & 63, gw = bx * 8 + (tid >> 6), nw = G * 8;
#pragma unroll 2
    for (int r = gw; r < NTOK; r += nw) {
        const int b = r / SEQ; f32x4 v[2][2]; float ss = 0.f;
#pragma unroll
        for (int j = 0; j < 2; ++j) { const size_t off = (size_t)r * DM + j * 512 + lane * 8;
            if (IN16) { const u32x4 w = *(const u32x4*)(x16 + off); v[j][0] = (f32x4){bf_lo(w.x), bf_hi(w.x), bf_lo(w.y), bf_hi(w.y)}; v[j][1] = (f32x4){bf_lo(w.z), bf_hi(w.z), bf_lo(w.w), bf_hi(w.w)}; }
            else { v[j][0] = *(const f32x4*)(x32 + off); v[j][1] = *(const f32x4*)(x32 + off + 4); }
#pragma unroll
            for (int q = 0; q < 2; ++q) ss += (v[j][q][0] * v[j][q][0] + v[j][q][1] * v[j][q][1]) + (v[j][q][2] * v[j][q][2] + v[j][q][3] * v[j][q][3]); }
#pragma unroll
        for (int o = 32; o >= 1; o >>= 1) ss += __shfl_xor(ss, o);
        const float rs = rsqrtf(ss * (1.0f / 1024.0f) + 1e-6f);
#pragma unroll
        for (int j = 0; j < 2; ++j) { const int col = j * 512 + lane * 8; f32x4 y[2];
#pragma unroll
            for (int q = 0; q < 2; ++q) { const f32x4 gg = *(const f32x4*)(g + col + 4 * q), sc = *(const f32x4*)(mod + (size_t)b * MODW + scoff + col + 4 * q), sh = *(const f32x4*)(mod + (size_t)b * MODW + shoff + col + 4 * q);
                y[q] = (v[j][q] * rs) * gg * (sc + 1.0f) + sh; }
            if (FINAL) { *(f32x4*)(outf + (size_t)r * DM + col) = y[0]; *(f32x4*)(outf + (size_t)r * DM + col + 4) = y[1]; }
            else *(u32x4*)(h + (size_t)r * DM + col) = pack8(y[0], y[1]); }
    }
}

#define XB_TMO      128
#define XB_XCNT(j)  (256  + 64 * (j))
#define XB_XSUB(j)  (1280 + 64 * (j))
#define XB_XGEN(j)  (2304 + 64 * (j))
#define XB_TOP      3328
#define XB_TOPGEN   3392
#define XCD_BAR_WORDS 3456
#define XB_SPIN_CAP (1u << 18)
__device__ __forceinline__ unsigned xb_ld(unsigned* p)              { return __hip_atomic_load(p, __ATOMIC_RELAXED, __HIP_MEMORY_SCOPE_AGENT); }
__device__ __forceinline__ unsigned xb_add(unsigned* p, unsigned v) { return __hip_atomic_fetch_add(p, v, __ATOMIC_RELAXED, __HIP_MEMORY_SCOPE_AGENT); }
__device__ __forceinline__ unsigned xb_xcc_id() { return (unsigned)__builtin_amdgcn_s_getreg((3 << 11) | 20) & 0xFu; }
#define XB_SPIN(cond, bar) do { unsigned _sp = 0; while (cond) { __builtin_amdgcn_s_sleep(1); \
    if ((++_sp & 255u) == 0u) { if (xb_ld(&(bar)[XB_TMO])) break; if (_sp > XB_SPIN_CAP) { atomicAdd(&(bar)[XB_TMO], 1u); break; } } } } while (0)
__device__ __forceinline__ void xcd_barrier_complete(unsigned* bar, unsigned x, unsigned& nloc, unsigned& nx) {
    const unsigned G = gridDim.x * gridDim.y * gridDim.z;
    unsigned sum, cnt, mine, sp = 0u;
    for (;;) {
        sum = 0u; cnt = 0u; mine = 0u;
#pragma unroll
        for (unsigned j = 0; j < 16; ++j) { const unsigned c = xb_ld(&bar[XB_XCNT(j)]); sum += c; cnt += (c > 0u) ? 1u : 0u; mine = (j == x) ? c : mine; }
        if (sum == G) break;
        __builtin_amdgcn_s_sleep(1);
        if ((++sp & 255u) == 0u) { if (xb_ld(&bar[XB_TMO])) break; if (sp > XB_SPIN_CAP) { atomicAdd(&bar[XB_TMO], 1u); break; } }
    }
    nloc = mine > 0u ? mine : 1u; nx = cnt > 0u ? cnt : 1u;
}
__device__ __forceinline__ void xcd_barrier(unsigned* bar, volatile LAS unsigned* st, const int tid) {
    asm volatile("s_waitcnt vmcnt(0)" ::: "memory");
    __syncthreads();
    if (tid == 0) {
        const unsigned x = xb_xcc_id();
        __builtin_amdgcn_s_waitcnt(0);
        unsigned nloc = st[0], nx = st[1];
        if (nloc == 0u) { xcd_barrier_complete(bar, x, nloc, nx); st[0] = nloc; st[1] = nx; }
        const unsigned old = xb_add(&bar[XB_XSUB(x)], 1u);
        const unsigned gen = old / nloc;
        if (old + 1u == (gen + 1u) * nloc) {
            __builtin_amdgcn_fence(__ATOMIC_RELEASE, "agent");
            asm volatile("s_waitcnt vmcnt(0)" ::: "memory");
            const unsigned og = xb_add(&bar[XB_TOP], 1u);
            const unsigned tg = og / nx;
            if (og + 1u == (tg + 1u) * nx) xb_add(&bar[XB_TOPGEN], 1u);
            else XB_SPIN(xb_ld(&bar[XB_TOPGEN]) == tg, bar);
            __builtin_amdgcn_fence(__ATOMIC_ACQUIRE, "agent");
            xb_add(&bar[XB_XGEN(x)], 1u);
            asm volatile("s_waitcnt vmcnt(0)" ::: "memory");
        } else {
            XB_SPIN(xb_ld(&bar[XB_XGEN(x)]) == gen, bar);
            __builtin_amdgcn_fence(__ATOMIC_ACQUIRE, "agent");
            asm volatile("s_waitcnt vmcnt(0)" ::: "memory");
        }
    }
    __syncthreads();
}

struct Params { const float* in[14]; float* out; unsigned char* ws; int ph_lo, ph_hi; };

enum { K_GEMV = 0, K_MODFIN, K_PREP, K_F1, K_FA, K_FB, K_N2, K_FF1, K_RESID, K_P1, K_P2S, K_PFX, K_P5, K_GATE, K_FINAL };
enum { R_F3 = 0, R_WOUT, R_FF2 };

__device__ __forceinline__ void plain_sched(GSched& S, int nM, int nN, int G, int c, const void* A, const void* B, int lda, int ldb) {
    S.o.init(nM, nN, 1, G, c); S.A = (const char*)A; S.B = (const char*)B; S.n1 = 1; S.n0 = 1;
    S.a2 = 0; S.a1 = 0; S.a0 = 0; S.apm = (unsigned)(2 * lda); S.b2 = 0; S.b1 = 0; S.b0 = 0; S.bpn = (unsigned)(2 * ldb);
}

__global__ void __launch_bounds__(512, 2) mega(Params p) {
    extern __shared__ __attribute__((aligned(16))) unsigned char shm[];
    {   volatile LAS unsigned* st0 = (volatile LAS unsigned*)((LAS unsigned char*)shm + STAGE_BYTES + 768);
        if (threadIdx.x == 0) { st0[0] = 0u; st0[1] = 0u; }
        __syncthreads();
        if (p.ph_lo == 0 && blockIdx.x == 0) { unsigned* bw = (unsigned*)(p.ws + WS_BAR); for (int i = threadIdx.x; i < XCD_BAR_WORDS; i += 512) bw[i] = 0u; }
    }
    for (int pph = p.ph_lo; pph < p.ph_hi; ++pph) {
        int ph = pph;
        if (PROBE_NDUP > 0) { const int dups[] = {PROBE_DUPS}; int sub = 0;
#pragma unroll
            for (int i = 0; i < PROBE_NDUP; ++i) sub += (dups[i] + i + 1 <= pph) ? 1 : 0;
            ph = pph - sub; }
        int tid_ = threadIdx.x, G_ = gridDim.x, bx_ = blockIdx.x; unsigned char* ws_ = p.ws; float* xres_ = p.out; unsigned ldsa = 0;
        asm volatile("" : "+v"(tid_), "+s"(G_), "+s"(bx_), "+s"(ldsa));
        const int tid = tid_, lane = tid & 63, wid = tid >> 6, G = G_, bx = bx_; unsigned char* const ws = ws_; float* const xres = xres_;
        LAS unsigned char* const lds = (LAS unsigned char*)shm + ldsa;
        int kind, l = 0, half = 0, rk = 0;
        if (ph < 2) kind = ph;
        else if (ph == 50) kind = K_FINAL;
        else {
            const int q = ph - 2, pair = q / 24, r = q % 24;
            if (r < 8) { l = 2 * pair; kind = r == 0 ? K_PREP : r == 1 ? K_F1 : r == 2 ? K_FA : r == 3 ? K_FB : r == 4 ? K_RESID : r == 5 ? K_N2 : r == 6 ? K_FF1 : K_RESID; rk = r == 4 ? R_F3 : R_FF2; }
            else { l = 2 * pair + 1; const int r2 = r - 8;
                if (r2 == 0) kind = K_PREP;
                else if (r2 <= 12) { half = (r2 - 1) / 6; const int sub = (r2 - 1) % 6; kind = sub == 0 ? K_P1 : sub == 1 ? K_P2S : sub == 2 ? K_PFX : sub == 3 ? K_P5 : sub == 4 ? K_GATE : K_RESID; rk = R_WOUT; }
                else { kind = r2 == 13 ? K_N2 : r2 == 14 ? K_FF1 : K_RESID; rk = R_FF2; } }
        }
        float* MOD = (float*)(ws + WS_MOD);
        const float* modl = MOD + l * 6144;
        bf16_t* const H = (bf16_t*)((unsigned char*)xres + 64 * MiB);
        bf16_t* const X16 = (bf16_t*)(ws + WS_H);
        switch (kind) {
        case K_GEMV: {
            const float* c_in = p.in[1]; const float* w_ada = p.in[2]; const float* w_ada_f = p.in[12];
            float* MODP = (float*)(ws + WS_MODP); float* ROPE = (float*)(ws + WS_ROPE); float* ROPET = (float*)(ws + WS_ROPET); bf16_t* CS = (bf16_t*)(ws + WS_CS);
            LAS float* cact = (LAS float*)lds;
            for (int i = tid; i < 8 * DM; i += 512) { const float v = c_in[i]; cact[i] = v / (1.0f + __expf(-v)); }
            __syncthreads();
            int vz = 0; asm volatile("" : "+v"(vz));
#pragma unroll 1
            for (int w = bx * 8 + wid; w < 104 * 16; w += G * 8) {
                const int cgp = w % 104, ks = w / 104, gc = cgp * 256 + lane * 4;
                const float* Wp; int ldw;
                if (gc < 24576) { const int ll = gc / 6144; Wp = w_ada + (size_t)ll * DM * 6144 + (gc - ll * 6144); ldw = 6144; } else { Wp = w_ada_f + (gc - 24576); ldw = 2048; }
                f32x4 a[8];
#pragma unroll
                for (int b = 0; b < 8; ++b) a[b] = (f32x4){0.f, 0.f, 0.f, 0.f};
#pragma unroll 4
                for (int k = ks * 64; k < ks * 64 + 64; ++k) { const f32x4 wv = *(const f32x4*)(Wp + (size_t)k * ldw);
#pragma unroll
                    for (int b = 0; b < 8; ++b) a[b] += wv * cact[b * DM + k + vz]; }
#pragma unroll
                for (int b = 0; b < 8; ++b) *(f32x4*)(MODP + ((size_t)(ks * 8 + b)) * MODW + gc) = a[b];
            }
#pragma unroll 1
            for (int idx = bx * 512 + tid; idx < SEQ * 128; idx += G * 512) {
                const int s = idx >> 7, i = idx & 127;
                const float invf = exp2f(-(float)i * (13.287712379549449f / 128.0f));
                const float ang = (float)s * invf;
                const double rev = (double)ang * 0.15915494309189535; const float fr_ = (float)(rev - floor(rev));
                const float sn = __builtin_amdgcn_sinf(fr_), cs = __builtin_amdgcn_cosf(fr_);
                *(f32x2*)(ROPE + (size_t)idx * 2) = (f32x2){cs, sn};
                *(f32x2*)(ROPET + ((size_t)i * SEQ + s) * 2) = (f32x2){cs, sn};
            }
#pragma unroll 1
            for (int idx = bx * 512 + tid; idx < 512 * 256; idx += G * 512) {
                const int row = idx >> 8, d = idx & 255, j = row & 255, part = row >> 8; const float fr_ = (float)((j * d) & 255) * (1.0f / 256.0f);
                const float v = (part ? __builtin_amdgcn_sinf(fr_) : __builtin_amdgcn_cosf(fr_)) * 0.0625f;
                CS[idx] = (bf16_t)(cvt_pk_bf16(v, 0.f) & 0xffffu);
            }
            {   bf16_t* TA = (bf16_t*)(ws + WS_TA); bf16_t* TB = (bf16_t*)(ws + WS_TB);
#pragma unroll 1
                for (int idx = bx * 512 + tid; idx < 256 * 128; idx += G * 512) {
                    const int row = idx >> 7, kk = idx & 127, pin = kk >> 6, sx = kk & 63;
                    float va = 0.f, vb = 0.f;
                    if (row < 128) { const int wr_ = row >> 6, m_ = (row >> 4) & 3, fr_ = row & 15, k1 = 32 * wr_ + 16 * (m_ >> 1) + fr_, pout = m_ & 1; const float th = (float)((k1 * sx) & 63) * (1.0f / 64.0f);
                        const float cs = __builtin_amdgcn_cosf(th), sn = __builtin_amdgcn_sinf(th); va = (pout == 0 ? (pin == 0 ? cs : -sn) : (pin == 0 ? -sn : -cs)) * 0.125f; }
                    if (row < 64) { const float th = (float)((row * sx) & 63) * (1.0f / 64.0f); vb = (pin == 0 ? __builtin_amdgcn_cosf(th) : __builtin_amdgcn_sinf(th)) * 0.125f; }
                    TA[idx] = (bf16_t)(cvt_pk_bf16(va, 0.f) & 0xffffu); TB[idx] = (bf16_t)(cvt_pk_bf16(vb, 0.f) & 0xffffu);
                } }
        } break;
        case K_MODFIN: {
            const float* b_ada = p.in[3]; const float* b_ada_f = p.in[13]; const float* MODP = (const float*)(ws + WS_MODP);
#pragma unroll 1
            for (int idx = bx * 512 + tid; idx < 8 * MODW; idx += G * 512) {
                const int b = idx / MODW, gc = idx % MODW; float s = gc < 24576 ? b_ada[gc] : b_ada_f[gc - 24576];
#pragma unroll
                for (int ks = 0; ks < 16; ++ks) s += MODP[((size_t)(ks * 8 + b)) * MODW + gc];
                MOD[idx] = s;
            }
        } break;
        case K_PREP: {
            const bool fourier = (l & 1) == 0; const int j = l >> 1;
            if (fourier) {
                conv_weight<0>(tid, p.in[6] + (size_t)j * DM * DM, DM, DM, (bf16_t*)(ws + W_MIXIN), bx, G);
            } else {
                conv_weight<0>(tid, p.in[7] + (size_t)j * DM * 6144, DM, 6144, (bf16_t*)(ws + W_MIXIN), bx, G);
                conv_weight<0>(tid, p.in[8] + (size_t)j * 2048 * DM, 2048, DM, (bf16_t*)(ws + W_MIXOUT), bx, G);
            }
            conv_weight<1>(tid, p.in[9] + (size_t)l * DM * 2 * DFF, DM, 2 * DFF, (bf16_t*)(ws + W_FFNIN), bx, G);
            conv_weight<0>(tid, p.in[10] + (size_t)l * DFF * DM, DFF, DM, (bf16_t*)(ws + W_FFNOUT), bx, G);
            __syncthreads();
            if (l == 0) norm_rows<false, false>(tid, bx, G, p.in[0], nullptr, p.in[4] + l * DM, modl, 0, 1024, H, nullptr);
            else norm_rows<true, false>(tid, bx, G, nullptr, X16, p.in[4] + l * DM, modl, 0, 1024, H, nullptr);
        } break;
        case K_F1: {
            GSched S; S.o.init(2, 16, 32, G, bx); S.A = (const char*)(ws + WS_CS); S.B = (const char*)H; S.n1 = 4; S.n0 = 8;
            S.a2 = 0; S.a1 = 0; S.a0 = 0; S.apm = 2 * 256; S.b2 = 0; S.b1 = 2; S.b0 = SEQ * 8; S.bpn = 4 * 8;
            EpiChanDft E{(bf16_t*)(ws + WS_Y1)};
            gemm_phase(tid, lds, S, E, 256, DM, 4);
        } break;
        case K_FA: {
            GSched S; plain_sched(S, 1, 2048, G, bx, ws + WS_TA, ws + WS_Y1, 128, 128);
            EpiFftA E{(bf16_t*)(ws + WS_Y2)};
            gemm_phase(tid, lds, S, E, 128, 128, 2);
        } break;
        case K_FB: {
            GSched S; plain_sched(S, 1, 2048, G, bx, ws + WS_TB, ws + WS_Y2, 128, 128);
            EpiFftB E{(bf16_t*)(ws + WS_FO)};
            gemm_phase(tid, lds, S, E, 128, 128, 2);
        } break;
        case K_N2: {
            norm_rows<true, false>(tid, bx, G, nullptr, X16, p.in[5] + l * DM, modl, 3072, 4096, H, nullptr);
        } break;
        case K_FF1: {
            GSched S; plain_sched(S, 128, 22, G, bx, H, ws + W_FFNIN, DM, DM);
            EpiSwiglu E{(bf16_t*)(ws + WS_HID)};
            gemm_phase(tid, lds, S, E, DM, DM, 16);
        } break;
        case K_RESID: {
            GSched S; EpiResid E; int ld, nt;
            if (rk == R_F3) { ld = DM; nt = 16; plain_sched(S, 128, 4, G, bx, ws + WS_FO, ws + W_MIXIN, ld, ld); E = EpiResid{l == 0 ? p.in[0] : nullptr, X16, X16, modl + 2048, 0}; }
            else if (rk == R_WOUT) { ld = 2048; nt = 32; plain_sched(S, 64, 4, G, bx, ws + WS_Y, ws + W_MIXOUT, ld, ld); E = EpiResid{nullptr, X16, X16, modl + 2048, half * HTOK}; }
            else { ld = DFF; nt = 44; plain_sched(S, 128, 4, G, bx, ws + WS_HID, ws + W_FFNOUT, ld, ld); E = EpiResid{nullptr, X16, X16, modl + 5120, 0}; }
            gemm_phase(tid, lds, S, E, ld, ld, nt);
        } break;
        case K_P1: {
            const bf16_t* Hh = H + (size_t)half * HTOK * DM; const bf16_t* WTin = (const bf16_t*)(ws + W_MIXIN);
            { GSched S; plain_sched(S, 64, 8, G, bx, Hh, WTin, DM, DM);
              EpiQK E{(bf16_t*)(ws + WS_A2), (bf16_t*)(ws + WS_KTM), (const float*)(ws + WS_ROPE)};
              gemm_phase(tid, lds, S, E, DM, DM, 16); }
            { GSched S; plain_sched(S, 12, 64, G, bx, WTin + (size_t)1024 * DM, Hh, DM, DM);
              EpiKVT E{(bf16_t*)(ws + WS_KFT), (bf16_t*)(ws + WS_KBT), (bf16_t*)(ws + WS_B2), (const float*)(ws + WS_ROPET)};
              gemm_phase(tid, lds, S, E, DM, DM, 16); }
        } break;
        case K_P2S: {
            bf16_t* A2 = (bf16_t*)(ws + WS_A2); bf16_t* B2 = (bf16_t*)(ws + WS_B2);
            { StateSched S{(const char*)B2, (const char*)(ws + WS_KFT), G, bx};
              EpiState E{B2};
              gemm_phase(tid, lds, S, E, 1024, SEQ, 8); }
            { GSched S; S.o.init(2, 2, 128, G, G - 1 - bx); S.A = (const char*)(A2 + 512); S.B = (const char*)(ws + WS_KTM); S.n1 = 4; S.n0 = 8;
              S.a2 = SEQ * 32; S.a1 = 8; S.a0 = 512 * 32; S.apm = 256 * 32;
              S.b2 = SEQ * 8; S.b1 = 2; S.b0 = 512 * 8; S.bpn = 256 * 8;
              EpiScores E{A2};
              gemm_phase(tid, lds, S, E, 4096, DM, 4); }
        } break;
        case K_PFX: {
            bf16_t* B2 = (bf16_t*)(ws + WS_B2);
#pragma unroll 1
            for (int it = bx * 512 + tid; it < 16 * 512 * 64; it += G * 512) {
                const int c8 = it & 63, dv = (it >> 6) & 511, bh = it >> 15, dir = c8 >> 5, h = bh & 3;
                const float dec = exp2f(512.0f * lg2gamma(dir ? 3 - h : h));
                bf16_t* p0 = B2 + ((size_t)(bh * 8) * 512 + dv) * 1024 + 512 + c8 * 8;
                float R[8];
#pragma unroll
                for (int e = 0; e < 8; ++e) R[e] = 0.f;
                u32x4 sv[7];
#pragma unroll
                for (int k = 0; k < 7; ++k) { const int slot = dir ? 6 - k : k + 1; sv[k] = *(const u32x4*)(p0 + (size_t)slot * 512 * 1024); }
                { unsigned zz = 0; asm volatile("" : "+v"(zz)); *(u32x4*)(p0 + (size_t)(dir ? 7 : 0) * 512 * 1024) = (u32x4){zz, zz, zz, zz}; }
#pragma unroll
                for (int k = 0; k < 7; ++k) { const int slot = dir ? 6 - k : k + 1; const u32x4 w = sv[k];
                    const float s[8] = {bf_lo(w.x), bf_hi(w.x), bf_lo(w.y), bf_hi(w.y), bf_lo(w.z), bf_hi(w.z), bf_lo(w.w), bf_hi(w.w)};
#pragma unroll
                    for (int e = 0; e < 8; ++e) R[e] = R[e] * dec + s[e];
                    u32x4 o; o.x = cvt_pk_bf16(R[0], R[1]); o.y = cvt_pk_bf16(R[2], R[3]); o.z = cvt_pk_bf16(R[4], R[5]); o.w = cvt_pk_bf16(R[6], R[7]);
                    *(u32x4*)(p0 + (size_t)slot * 512 * 1024) = o; }
            }
        } break;
        case K_P5: {
            GSched S; S.o.init(2, 2, 128, G, bx); S.A = (const char*)(ws + WS_A2); S.B = (const char*)(ws + WS_B2); S.n1 = 4; S.n0 = 8;
            S.a2 = SEQ * 32; S.a1 = 8; S.a0 = 512 * 32; S.apm = 256 * 32;
            S.b2 = 32 * 512 * 8; S.b1 = 8 * 512 * 8; S.b0 = 512 * 8; S.bpn = 256 * 8;
            EpiRetOut E{(bf16_t*)(ws + WS_Y), (float*)(ws + WS_STATS)};
            gemm_phase(tid, lds, S, E, 4096, 1024, 16);
        } break;
        case K_GATE: {
            GSched S; plain_sched(S, 64, 8, G, bx, H + (size_t)half * HTOK * DM, (const bf16_t*)(ws + W_MIXIN) + (size_t)4096 * DM, DM, DM);
            EpiGate E{(bf16_t*)(ws + WS_Y), (const float*)(ws + WS_STATS)};
            gemm_phase(tid, lds, S, E, DM, DM, 16);
        } break;
        default: {
            norm_rows<true, true>(tid, bx, G, nullptr, X16, p.in[11], MOD + 24576, 0, 1024, nullptr, xres);
        } break;
        }
        if (pph + 1 < p.ph_hi) {
            if (pph == p.ph_lo) { cg::this_grid().sync();
                if (tid == 0) (void)xb_add(&((unsigned*)(ws + WS_BAR))[XB_XCNT(xb_xcc_id())], 1u); }
            else xcd_barrier((unsigned*)(ws + WS_BAR), (volatile LAS unsigned*)(lds + STAGE_BYTES + 768), tid);
        }
    }
}
constexpr int N_PHASES = 2 + 2 * (1 + 4 + 3) + 2 * (1 + 12 + 3) + 1 + PROBE_NDUP;

extern "C" void kernel_launch(void* const* d_in, const int* in_sizes, int n_in, void* d_out, int out_size, void* d_ws, size_t ws_size, hipStream_t stream) {
    static int grid = 0;
    if (grid == 0) {
        if (n_in != 14 || ws_size < WS_END) { fprintf(stderr, "kernel_launch: unexpected n_in %d or ws_size %zu (< %zu)\n", n_in, ws_size, (size_t)WS_END); grid = -1; return; }
        int dev = 0, cus = 0, per_cu = 0;
        hipGetDevice(&dev); hipDeviceGetAttribute(&cus, hipDeviceAttributeMultiprocessorCount, dev);
        if (hipFuncSetAttribute((const void*)mega, hipFuncAttributeMaxDynamicSharedMemorySize, LDS_BYTES) != hipSuccess) { fprintf(stderr, "kernel_launch: hipFuncSetAttribute failed\n"); grid = -1; return; }
        hipOccupancyMaxActiveBlocksPerMultiprocessor(&per_cu, (const void*)mega, 512, LDS_BYTES);
        (void)hipGetLastError();
        if (per_cu < 1) { fprintf(stderr, "kernel_launch: occupancy query says %d blocks per CU\n", per_cu); per_cu = 1; }
        grid = cus;
    }
    if (grid < 0) return;
    Params p{};
    for (int i = 0; i < 14; ++i) p.in[i] = (const float*)d_in[i];
    p.out = (float*)d_out; p.ws = (unsigned char*)d_ws;
#if MULTI_LAUNCH
    for (int k = 0; k < N_PHASES; ++k) { p.ph_lo = k; p.ph_hi = k + 1; hipLaunchKernelGGL(mega, dim3(grid), dim3(512), LDS_BYTES, stream, p); }
#else
    p.ph_lo = 0; p.ph_hi = N_PHASES;
    void* args[] = {&p};
    hipError_t e = hipLaunchCooperativeKernel((const void*)mega, dim3(grid), dim3(512), args, LDS_BYTES, stream);
    if (e != hipSuccess) fprintf(stderr, "cooperative launch failed: %s (grid %d)\n", hipGetErrorString(e), grid);
#endif
}
```
